# Optimizing an MI355X kernel written in HIP

```python
import math
import jax, jax.numpy as jnp
from jax import lax
import numpy as np

D_MODEL = 1024
BATCH = 4
SEQ = 4096
DEPTH = 2
DEC_BATCH = 4
DEC_SEQ = 8192
PAST_LEN = 128

N_MEM = 256
BRANCH_W = 512
N_BRANCH = 5
Q_BLOCK = 128
NEG_INF = -1e30
EPS = 1e-6
A_HEADS = 4
A_DK = 64
A_DV = 128
B_HEADS = 4
B_Q_LORA = 256
B_KV_LORA = 128
B_NOPE = 64
B_ROPE = 32
B_DV = 128
ROPE_THETA = 10000.0
C_QH = 8
C_KVH = 2
C_HD = 64
C_WINDOW = 128
C_BLOCK = 128
D_HEADS = 8
D_HD = 64
DIL_PAIRS = ((128, 1), (512, 4), (2048, 16))
N_DIL = 3
M_HEADS = 4
M_HD = 128

IN_LAYOUT = (
    ("a_q", 2 * A_HEADS * A_DK), ("a_k", 2 * A_HEADS * A_DK), ("a_v", A_HEADS * A_DV),
    ("b_cq", B_Q_LORA), ("b_ckv", B_KV_LORA), ("b_kr", B_ROPE),
    ("c_q", C_QH * C_HD), ("c_k", C_KVH * C_HD), ("c_v", C_KVH * C_HD),
    ("d_q", N_DIL * D_HEADS * D_HD), ("d_k", N_DIL * D_HEADS * D_HD), ("d_v", N_DIL * D_HEADS * D_HD),
    ("m_q", M_HEADS * M_HD),
    ("z", N_BRANCH * BRANCH_W),
    ("g", N_BRANCH * D_MODEL),
)
N_IN = sum(size for _, size in IN_LAYOUT)

kernel_name = "hybrid_gated_bidir_encoder"


def rms_norm(x, g):
    xf = x.astype(jnp.float32)
    y = xf * lax.rsqrt(jnp.mean(xf * xf, axis=-1, keepdims=True) + EPS)
    return (y * g.astype(jnp.float32)).astype(x.dtype)


def alibi_slopes(n):
    return 2.0 ** (-8.0 * jnp.arange(1, n + 1, dtype=jnp.float32) / n)


def rope_tables(S):
    half = B_ROPE // 2
    inv = ROPE_THETA ** (-jnp.arange(half, dtype=jnp.float32) / half)
    ang = jnp.arange(S, dtype=jnp.float32)[:, None] * inv[None, :]
    return jnp.cos(ang), jnp.sin(ang)


def apply_rope(x, cos, sin):
    half = x.shape[-1] // 2
    xf = x.astype(jnp.float32)
    x1, x2 = xf[..., :half], xf[..., half:]
    return jnp.concatenate([x1 * cos - x2 * sin, x2 * cos + x1 * sin], axis=-1).astype(x.dtype)


def to_blocks(t):
    B, S = t.shape[:2]
    return jnp.moveaxis(t.reshape(B, S // Q_BLOCK, Q_BLOCK, *t.shape[2:]), 1, 0)


def from_blocks(t):
    nb, B, qb = t.shape[:3]
    return jnp.moveaxis(t, 0, 1).reshape(B, nb * qb, *t.shape[3:])


def split_columns(proj):
    parts, start = {}, 0
    for name, size in IN_LAYOUT:
        parts[name] = proj[..., start:start + size]
        start += size
    return parts


def diff_attention(q, k, v, lam):
    S = q.shape[1]
    pos = jnp.arange(S)
    slopes = alibi_slopes(q.shape[3])
    scale = q.shape[-1] ** -0.5

    def block(args):
        qb, qp = args
        s = jnp.einsum("bqmhd,bkmhd->bmhqk", qb, k).astype(jnp.float32) * scale
        bias = -slopes[:, None, None] * jnp.abs(qp[:, None] - pos[None, :])
        p = jax.nn.softmax(s + bias, axis=-1)
        a = p[:, 0] - lam * p[:, 1]
        return jnp.einsum("bhqk,bkhd->bqhd", a.astype(v.dtype), v)

    return from_blocks(lax.map(block, (to_blocks(q), pos.reshape(-1, Q_BLOCK))))


def mla_attention(qn, qr, kn, kr, v):
    scale = (qn.shape[-1] + qr.shape[-1]) ** -0.5

    def block(args):
        qnb, qrb = args
        s = (jnp.einsum("bqhd,bkhd->bhqk", qnb, kn)
             + jnp.einsum("bqhr,bkr->bhqk", qrb, kr)).astype(jnp.float32) * scale
        p = jax.nn.softmax(s, axis=-1)
        return jnp.einsum("bhqk,bkhd->bqhd", p.astype(v.dtype), v)

    return from_blocks(lax.map(block, (to_blocks(qn), to_blocks(qr))))


def window_gqa(q, k, v, sink):
    B, S, Hq, hd = q.shape
    Hkv = k.shape[2]
    G = Hq // Hkv
    nb = S // C_BLOCK
    scale = hd ** -0.5
    qb = q.reshape(B, nb, C_BLOCK, Hkv, G, hd)

    def band(t):
        tp = jnp.pad(t, ((0, 0), (C_BLOCK, C_BLOCK), (0, 0), (0, 0))).reshape(B, nb + 2, C_BLOCK, Hkv, hd)
        return jnp.concatenate([tp[:, :-2], tp[:, 1:-1], tp[:, 2:]], axis=2)

    kb, vb = band(k), band(v)
    s = jnp.einsum("bnqhgd,bnkhd->bnhgqk", qb, kb).astype(jnp.float32) * scale
    koff = jnp.arange(3 * C_BLOCK) - C_BLOCK
    rel = koff[None, :] - jnp.arange(C_BLOCK)[:, None]
    kabs = jnp.arange(nb)[:, None] * C_BLOCK + koff[None, :]
    valid = (jnp.abs(rel) <= C_WINDOW)[None] & ((kabs >= 0) & (kabs < S))[:, None, :]
    slopes = alibi_slopes(Hq).reshape(Hkv, G)
    logits = s - slopes[:, :, None, None] * jnp.abs(rel)
    logits = jnp.where(valid[None, :, None, None], logits, NEG_INF)
    sink_l = jnp.broadcast_to(sink.astype(jnp.float32).reshape(Hkv, G)[:, :, None, None],
                              logits.shape[:-1] + (1,))
    p = jax.nn.softmax(jnp.concatenate([logits, sink_l], axis=-1), axis=-1)[..., :-1]
    o = jnp.einsum("bnhgqk,bnkhd->bnqhgd", p.astype(v.dtype), vb)
    return o.reshape(B, S, Hq, hd)


def dilated_attention(q, k, v):
    S, H = q.shape[1], q.shape[3]
    scale = q.shape[-1] ** -0.5
    slopes = alibi_slopes(H)
    pos = jnp.arange(S)
    ks = [k[:, :, g] for g in range(N_DIL)]
    vs = [v[:, :, g] for g in range(N_DIL)]
    offsets = [dil * jnp.arange(-(w // (2 * dil)), w // (2 * dil) + 1) for w, dil in DIL_PAIRS]

    def block(args):
        qb, qp = args
        outs, lses = [], []
        for g in range(N_DIL):
            off = offsets[g]
            idx = qp[:, None] + off[None, :]
            valid = (idx >= 0) & (idx < S)
            idx = jnp.clip(idx, 0, S - 1)
            kg = jnp.take(ks[g], idx, axis=1)
            vg = jnp.take(vs[g], idx, axis=1)
            s = jnp.einsum("bqhd,bqjhd->bhqj", qb[:, :, g], kg).astype(jnp.float32) * scale
            s = s - slopes[:, None, None] * jnp.abs(off)[None, None, :]
            s = jnp.where(valid[None, None], s, NEG_INF)
            m = jnp.max(s, axis=-1, keepdims=True)
            e = jnp.exp(s - m)
            den = jnp.sum(e, axis=-1, keepdims=True)
            outs.append(jnp.einsum("bhqj,bqjhd->bqhd", (e / den).astype(v.dtype), vg))
            lses.append((m + jnp.log(den))[..., 0])
        w = jax.nn.softmax(jnp.stack(lses, axis=0), axis=0)
        w = jnp.swapaxes(w, 2, 3)[..., None]
        return jnp.sum(w * jnp.stack(outs, axis=0).astype(jnp.float32), axis=0).astype(v.dtype)

    return from_blocks(lax.map(block, (to_blocks(q), pos.reshape(-1, Q_BLOCK))))


def memory_attention(q, k, v):
    scale = q.shape[-1] ** -0.5
    s = jnp.einsum("bqhd,bkhd->bhqk", q, k).astype(jnp.float32) * scale
    p = jax.nn.softmax(s, axis=-1)
    return jnp.einsum("bhqk,bkhd->bqhd", p.astype(v.dtype), v)


def encoder_layer(x, mem, layer_idx, p):
    B, S, _ = x.shape
    h = rms_norm(x, p["norm_g"])
    parts = split_columns(h @ p["w_in"])

    aq = rms_norm(parts["a_q"].reshape(B, S, 2, A_HEADS, A_DK), p["a_qn"])
    ak = rms_norm(parts["a_k"].reshape(B, S, 2, A_HEADS, A_DK), p["a_kn"])
    av = parts["a_v"].reshape(B, S, A_HEADS, A_DV)
    lam_init = 0.8 - 0.6 * math.exp(-0.3 * layer_idx)
    lf = p["a_lam"].astype(jnp.float32)
    lam = jnp.exp(jnp.sum(lf[0] * lf[1])) - jnp.exp(jnp.sum(lf[2] * lf[3])) + lam_init
    oa = diff_attention(aq, ak, av, lam)
    oa = (rms_norm(oa, p["a_hn"]) * (1.0 - lam_init)).reshape(B, S, BRANCH_W)

    cq = rms_norm(parts["b_cq"], p["b_cqn"])
    qb = (cq @ p["w_qb"]).reshape(B, S, B_HEADS, B_NOPE + B_ROPE)
    ckv = rms_norm(parts["b_ckv"], p["b_ckvn"])
    kvb = (ckv @ p["w_kvb"]).reshape(B, S, B_HEADS, B_NOPE + B_DV)
    cos, sin = rope_tables(S)
    qn = rms_norm(qb[..., :B_NOPE], p["b_qn"][:B_NOPE])
    qr = apply_rope(rms_norm(qb[..., B_NOPE:], p["b_qn"][B_NOPE:]), cos[:, None], sin[:, None])
    kn = rms_norm(kvb[..., :B_NOPE], p["b_kn"][:B_NOPE])
    kr = apply_rope(rms_norm(parts["b_kr"], p["b_kn"][B_NOPE:]), cos, sin)
    ob = mla_attention(qn, qr, kn, kr, kvb[..., B_NOPE:]).reshape(B, S, BRANCH_W)

    cq_ = rms_norm(parts["c_q"].reshape(B, S, C_QH, C_HD), p["c_qn"])
    ck = rms_norm(parts["c_k"].reshape(B, S, C_KVH, C_HD), p["c_kn"])
    cv = parts["c_v"].reshape(B, S, C_KVH, C_HD)
    oc = window_gqa(cq_, ck, cv, p["c_sink"]).reshape(B, S, BRANCH_W)

    dq = rms_norm(parts["d_q"].reshape(B, S, N_DIL, D_HEADS, D_HD), p["d_qn"])
    dk = rms_norm(parts["d_k"].reshape(B, S, N_DIL, D_HEADS, D_HD), p["d_kn"])
    dv = parts["d_v"].reshape(B, S, N_DIL, D_HEADS, D_HD)
    od = dilated_attention(dq, dk, dv).reshape(B, S, BRANCH_W)

    mn = rms_norm(mem, p["m_norm"])
    mkv = (mn @ p["w_mem_kv"]).reshape(B, mem.shape[1], 2, M_HEADS, M_HD)
    mq = rms_norm(parts["m_q"].reshape(B, S, M_HEADS, M_HD), p["m_qn"])
    mk = rms_norm(mkv[:, :, 0], p["m_kn"])
    om = memory_attention(mq, mk, mkv[:, :, 1]).reshape(B, S, BRANCH_W)

    z, g = parts["z"], parts["g"]
    acc = jnp.zeros_like(x)
    for i, o in enumerate((oa, ob, oc, od, om)):
        zi = jax.nn.silu(z[..., i * BRANCH_W:(i + 1) * BRANCH_W])
        gi = jax.nn.sigmoid(g[..., i * D_MODEL:(i + 1) * D_MODEL] + p["b_gate"][i])
        acc = acc + gi * ((o * zi) @ p["w_br"][i])
    return x + acc @ p["w_out"]


def setup_inputs(seed: int = 0) -> dict:
    key = jax.random.key(seed)
    ks = jax.random.split(key, 32)
    L, D = DEPTH, D_MODEL
    f32 = jnp.float32

    def nrm(k, shape, scale):
        return jax.random.normal(k, shape, f32) * scale

    def gain(k, shape):
        return 1.0 + 0.01 * jax.random.normal(k, shape, f32)

    return {
        "x_prompt": nrm(ks[0], (BATCH, SEQ, D), 1.0),
        "x_sample": nrm(ks[1], (DEC_BATCH, DEC_SEQ, D), 1.0),
        "mem_prompt": nrm(ks[2], (BATCH, N_MEM, D), 1.0),
        "mem_sample": nrm(ks[3], (DEC_BATCH, N_MEM, D), 1.0),
        "norm_g": gain(ks[4], (L, D)),
        "w_in": nrm(ks[5], (L, D, N_IN), D ** -0.5),
        "a_qn": gain(ks[6], (L, A_DK)),
        "a_kn": gain(ks[7], (L, A_DK)),
        "a_lam": nrm(ks[8], (L, 4, A_DK), 0.1),
        "a_hn": gain(ks[9], (L, A_DV)),
        "b_cqn": gain(ks[10], (L, B_Q_LORA)),
        "b_ckvn": gain(ks[11], (L, B_KV_LORA)),
        "w_qb": nrm(ks[12], (L, B_Q_LORA, B_HEADS * (B_NOPE + B_ROPE)), B_Q_LORA ** -0.5),
        "w_kvb": nrm(ks[13], (L, B_KV_LORA, B_HEADS * (B_NOPE + B_DV)), B_KV_LORA ** -0.5),
        "b_qn": gain(ks[14], (L, B_NOPE + B_ROPE)),
        "b_kn": gain(ks[15], (L, B_NOPE + B_ROPE)),
        "c_qn": gain(ks[16], (L, C_HD)),
        "c_kn": gain(ks[17], (L, C_HD)),
        "c_sink": nrm(ks[18], (L, C_QH), 0.5),
        "d_qn": gain(ks[19], (L, D_HD)),
        "d_kn": gain(ks[20], (L, D_HD)),
        "m_norm": gain(ks[21], (L, D)),
        "w_mem_kv": nrm(ks[22], (L, D, 2 * M_HEADS * M_HD), D ** -0.5),
        "m_qn": gain(ks[23], (L, M_HD)),
        "m_kn": gain(ks[24], (L, M_HD)),
        "b_gate": nrm(ks[25], (L, N_BRANCH, D), 0.01),
        "w_br": nrm(ks[26], (L, N_BRANCH, BRANCH_W, D), BRANCH_W ** -0.5),
        "w_out": nrm(ks[27], (L, D, D), D ** -0.5),
    }


def reference(x_prompt, x_sample, mem_prompt, mem_sample, norm_g, w_in, a_qn, a_kn, a_lam, a_hn,
              b_cqn, b_ckvn, w_qb, w_kvb, b_qn, b_kn, c_qn, c_kn, c_sink, d_qn, d_kn,
              m_norm, w_mem_kv, m_qn, m_kn, b_gate, w_br, w_out):
    y_prompt, y_sample = x_prompt, x_sample
    for l in range(DEPTH):
        p = {
            "norm_g": norm_g[l], "w_in": w_in[l],
            "a_qn": a_qn[l], "a_kn": a_kn[l], "a_lam": a_lam[l], "a_hn": a_hn[l],
            "b_cqn": b_cqn[l], "b_ckvn": b_ckvn[l], "w_qb": w_qb[l], "w_kvb": w_kvb[l],
            "b_qn": b_qn[l], "b_kn": b_kn[l],
            "c_qn": c_qn[l], "c_kn": c_kn[l], "c_sink": c_sink[l],
            "d_qn": d_qn[l], "d_kn": d_kn[l],
            "m_norm": m_norm[l], "w_mem_kv": w_mem_kv[l], "m_qn": m_qn[l], "m_kn": m_kn[l],
            "b_gate": b_gate[l], "w_br": w_br[l], "w_out": w_out[l],
        }
        y_prompt = encoder_layer(y_prompt, mem_prompt, l, p)
        y_sample = encoder_layer(y_sample, mem_sample, l, p)
    return (y_prompt, y_sample)
```

```cpp
#include <hip/hip_runtime.h>
#include <hip/hip_cooperative_groups.h>
#include <cstdio>
#include <cstdint>
namespace cg = cooperative_groups;

#define LAS __attribute__((address_space(3)))
#define DI __device__ __forceinline__
typedef unsigned short bf16_t;
typedef short bf16x8 __attribute__((ext_vector_type(8)));
typedef short s16x4 __attribute__((ext_vector_type(4)));
typedef float f32x4 __attribute__((ext_vector_type(4)));
typedef float f32x16 __attribute__((ext_vector_type(16)));
typedef unsigned u32x4 __attribute__((ext_vector_type(4)));
typedef unsigned u32x2 __attribute__((ext_vector_type(2)));

constexpr int DM = 1024, NIN = 15520, TU = 16384  , NUNIT = 3, DEPTH = 2;
constexpr int PQ = 4608, PKV = 4864, PMLA = 1280, PBK = 384, PGATE = 5120, PMKV = 1024;
constexpr int NG1 = 7936, NZ = 2560, NGT = 5120, NWIN = NG1 + NZ + NGT;
constexpr float LOG2E = 1.4426950408889634f, EPS = 1e-6f;
constexpr int QC_AQ = 0, QC_CQ = 512, QC_DQ = 1024, QC_MQ = 2560, QC_OA = 3072, QC_OB = 4096;
constexpr int KC_AK = 0, KC_AV = 512, KC_CK = 1024, KC_CV = 1152, KC_DK = 1280, KC_DV = 2816, KC_CQ = 4352, KC_CKV = 4608, KC_KR = 4736;
constexpr size_t MiB = 1u << 20;
constexpr size_t WS_ROPE = 1 * MiB, WS_WIN = 2 * MiB, WS_WMLA = 33 * MiB, WS_WMEM = 34 * MiB, WS_WBR = 38 * MiB, WS_WOUT = 43 * MiB,
                 WS_MN = 45 * MiB, WS_MKV = 47 * MiB, WS_LSE = 51 * MiB, WS_H = 54 * MiB, WS_QB = 86 * MiB, WS_KVB = 230 * MiB,
                 WS_MLA = 382 * MiB, WS_BK = 422 * MiB, WS_GATE = 230 * MiB, WS_END = 434 * MiB;
constexpr int LDS_BYTES = 131072 + 256;

#define DBG_SEL1 9
#define DBG_SEL2 10
#ifdef DBG
#define DBG_PH_HI 11
#else
#define DBG_PH_HI 62
#endif
#ifndef DBG_BMASK
#define DBG_BMASK 31
#endif
struct Args { const float* in[28]; float* out; unsigned char* ws; int ph_lo, ph_hi, coop, pad; };

DI float bf2f(unsigned short b) { return __uint_as_float(((unsigned)b) << 16); }
typedef __bf16 bf16x2_t __attribute__((ext_vector_type(2)));
typedef float f32x2_t __attribute__((ext_vector_type(2)));
DI unsigned cvt_pk(float lo, float hi) { const f32x2_t v = {lo, hi}; const bf16x2_t b = __builtin_convertvector(v, bf16x2_t); return __builtin_bit_cast(unsigned, b); }
DI void unpack8(const u32x4 w, float* v) {
#pragma unroll
  for (int i = 0; i < 4; ++i) { v[2 * i] = __uint_as_float(w[i] << 16); v[2 * i + 1] = __uint_as_float(w[i] & 0xffff0000u); }
}
DI u32x4 pack8(const float* v) { u32x4 w; w.x = cvt_pk(v[0], v[1]); w.y = cvt_pk(v[2], v[3]); w.z = cvt_pk(v[4], v[5]); w.w = cvt_pk(v[6], v[7]); return w; }
DI float fexp2(float x) { return __builtin_amdgcn_exp2f(x); }
DI float sigmoidf_(float x) { return __builtin_amdgcn_rcpf(1.0f + fexp2(-x * LOG2E)); }

namespace pg8 {
constexpr int BM = 256, BK = 64, HALF = 128, HTB = HALF * BK * 2, NXCD = 8, WGM = 8;
__host__ __device__ __forceinline__ int lds_byte(int r, int c) { const int st = (r >> 4) * 2 + (c >> 5), rr = r & 15, cc = c & 31, ob = rr * 64 + cc * 2; return st * 1024 + (ob ^ (((ob >> 9) & 1) << 5)); }
__host__ __device__ __forceinline__ void stage_rc(int b, int& R, int& C) { const int st = b / 1024, sb = b % 1024, swz = sb ^ (((sb >> 9) & 1) << 5); R = (st >> 1) * 16 + swz / 64; C = (st & 1) * 32 + (swz % 64) / 2; }
__host__ __device__ __forceinline__ int perm32(int rho) { const int n = rho >> 4, i = rho & 15; return 8 * (i >> 2) + 4 * n + (i & 3); }

struct Unit { const char* a; const char* b; int pm, pn, aux; };
struct Gemm { int lda, ldb, K; };

struct GridOrder {
  const char* A; const char* B; int lda, ldb, nM, nN, nwg, G, c;
  DI void init(const void* A_, int lda_, const void* B_, int ldb_, int M, int N, int G_, int c_) { A = (const char*)A_; B = (const char*)B_; lda = lda_; ldb = ldb_; nM = M / BM; nN = N / BM; nwg = nM * nN; G = G_; c = c_; }
  DI bool next(int i, Unit& u) const {
    const long L = (long)i * G + c; if (L >= nwg) return false;
    int wgid = (int)L; { const int q = nwg / NXCD, r = nwg % NXCD, xcd = wgid % NXCD, off = wgid / NXCD; wgid = (xcd < r ? xcd * (q + 1) : r * (q + 1) + (xcd - r) * q) + off; }
    const int nig = WGM * nN, gid = wgid / nig, fm = gid * WGM, gsz = (nM - fm) < WGM ? (nM - fm) : WGM;
    u.pm = fm + ((wgid % nig) % gsz); u.pn = (wgid % nig) / gsz; u.aux = 0;
    u.a = A + (size_t)u.pm * BM * lda * 2; u.b = B + (size_t)u.pn * BM * ldb * 2; return true;
  }
};
struct MergeOrder {
  const char* QBp; const char* WBR; int ntiles, G, c;
  DI bool next(int i, Unit& u) const {
    const int k = i / 5, br = i - k * 5; const int tile = c + k * G; if (tile >= ntiles) return false;
    u.pm = tile >> 2; u.pn = tile & 3; u.aux = br;
    const int ocol = br == 0 ? QC_OA : br == 1 ? QC_OB : br == 2 ? QC_CQ : br == 3 ? QC_DQ : QC_MQ;
    u.a = QBp + ((size_t)u.pm * BM * PQ + ocol) * 2; u.b = WBR + ((size_t)(br * 1024 + u.pn * BM) * 512) * 2; return true;
  }
};

template <class Epi, class Sched>
DI void gemm_phase(LAS unsigned char* lds, const Gemm g, const Sched& S, const Epi& E) {
  int tid = threadIdx.x; asm volatile("" : "+v"(tid));
  const int wid = __builtin_amdgcn_readfirstlane(tid >> 6), lane = tid & 63, wr = wid >> 2, wc = wid & 3, fr = lane & 15, fq = lane >> 4;
  const int K = g.K, nt = K / BK;
  unsigned voffA[2], voffB[2];
#pragma unroll
  for (int i = 0; i < 2; ++i) { int R, C; stage_rc(tid * 16 + i * 8192, R, C); const int Rb = (R & ~31) + perm32(R & 31);
    voffA[i] = (unsigned)(R * g.lda + C) * 2u; voffB[i] = (unsigned)(Rb * g.ldb + C) * 2u; }
  const size_t kstep = (size_t)(BK * 2);
  const size_t hstepA = (size_t)HALF * g.lda * 2, hstepB = (size_t)HALF * g.ldb * 2;
  const unsigned ldsw = (unsigned)wid * 1024u;
  const int aoff = lds_byte(wr * 64 + fr, fq * 8), boff = lds_byte(wc * 32 + fr, fq * 8);
#define PG8_SA(b, h) (((b) * 2 + (h)) * HTB)
#define PG8_SB(b, h) ((4 + (b) * 2 + (h)) * HTB)
#define PG8_STAGE(bufoff, gbase, voff) do { _Pragma("unroll") for (int _i = 0; _i < 2; ++_i) \
    __builtin_amdgcn_global_load_lds((const unsigned*)((const char*)(gbase) + (voff)[_i]), (LAS unsigned*)(lds + (bufoff) + ldsw + _i * 8192), 16, 0, 0); } while (0)
#define PG8_LDA(dst, b, h) do { _Pragma("unroll") for (int m = 0; m < 4; ++m) _Pragma("unroll") for (int k = 0; k < 2; ++k) dst[m][k] = *(const LAS bf16x8*)(lds + PG8_SA(b, h) + aoff + m * 2048 + k * 1024); } while (0)
#define PG8_LDB(dst, b, h) do { _Pragma("unroll") for (int n = 0; n < 2; ++n) _Pragma("unroll") for (int k = 0; k < 2; ++k) dst[n][k] = *(const LAS bf16x8*)(lds + PG8_SB(b, h) + boff + n * 2048 + k * 1024); } while (0)
#define PG8_MMA(ai, bj, At, Bt) do { __builtin_amdgcn_s_setprio(1); _Pragma("unroll") for (int m = 0; m < 4; ++m) _Pragma("unroll") for (int n = 0; n < 2; ++n) _Pragma("unroll") for (int k = 0; k < 2; ++k) \
    acc[ai][bj][m][n] = __builtin_amdgcn_mfma_f32_16x16x32_bf16(Bt[n][k], At[m][k], acc[ai][bj][m][n], 0, 0, 0); __builtin_amdgcn_s_setprio(0); } while (0)
#define PG8_WAIT_V(n) asm volatile("s_waitcnt vmcnt(" #n ")" ::: "memory")
#define PG8_WAIT_L(n) asm volatile("s_waitcnt lgkmcnt(" #n ")" ::: "memory")
#define PG8_BAR __builtin_amdgcn_s_barrier()
#define PG8_SCHED __builtin_amdgcn_sched_barrier(0)
  Unit cur, nxt; int ui = 0;
  if (!S.next(0, cur)) return;
  f32x4 acc[2][2][4][2];
#pragma unroll
  for (int a = 0; a < 2; ++a)
#pragma unroll
    for (int b = 0; b < 2; ++b)
#pragma unroll
      for (int m = 0; m < 4; ++m)
#pragma unroll
        for (int n = 0; n < 2; ++n) acc[a][b][m][n] = (f32x4){0.f, 0.f, 0.f, 0.f};
  bf16x8 At[4][2], B0[2][2], B1[2][2];
  const char* cA = cur.a; const char* cB = cur.b;
  PG8_STAGE(PG8_SB(0, 0), cB, voffB); PG8_STAGE(PG8_SB(0, 1), cB + hstepB, voffB); PG8_STAGE(PG8_SA(0, 0), cA, voffA); PG8_STAGE(PG8_SA(0, 1), cA + hstepA, voffA);
  if (wr == 1) PG8_BAR;
  PG8_WAIT_V(2); PG8_BAR;
  PG8_STAGE(PG8_SB(1, 0), cB + kstep, voffB); PG8_STAGE(PG8_SA(1, 0), cA + kstep, voffA); PG8_STAGE(PG8_SB(1, 1), cB + hstepB + kstep, voffB);
  PG8_WAIT_V(6); PG8_BAR;
  for (;;) {
    const bool has_next = S.next(ui + 1, nxt);
    const char* nA = has_next ? nxt.a : cA; const char* nB = has_next ? nxt.b : cB;
    for (int t = 0; t < nt; t += 2) {
      const bool last = (t == nt - 2);
      const char* a1 = cA + (size_t)(t + 1) * kstep;
      const char* a2 = last ? nA : cA + (size_t)(t + 2) * kstep; const char* b2 = last ? nB : cB + (size_t)(t + 2) * kstep;
      const char* a3 = a2 + kstep; const char* b3 = b2 + kstep;
      PG8_LDB(B0, 0, 0); PG8_LDB(B1, 0, 1); PG8_SCHED; PG8_LDA(At, 0, 0); PG8_STAGE(PG8_SA(1, 1), a1 + hstepA, voffA);
      PG8_WAIT_V(8); PG8_WAIT_L(0); PG8_BAR; PG8_MMA(0, 0, At, B0); PG8_MMA(0, 1, At, B1); PG8_BAR; PG8_SCHED;
      PG8_LDA(At, 0, 1); PG8_STAGE(PG8_SB(0, 0), b2, voffB); PG8_STAGE(PG8_SB(0, 1), b2 + hstepB, voffB); PG8_STAGE(PG8_SA(0, 0), a2, voffA);
      PG8_WAIT_V(8); PG8_WAIT_L(0); PG8_BAR; PG8_MMA(1, 0, At, B0); PG8_MMA(1, 1, At, B1); PG8_BAR; PG8_SCHED;
      PG8_LDB(B0, 1, 0); PG8_LDB(B1, 1, 1); PG8_SCHED; PG8_LDA(At, 1, 0); PG8_STAGE(PG8_SA(0, 1), a2 + hstepA, voffA);
      PG8_WAIT_V(8); PG8_WAIT_L(0); PG8_BAR; PG8_MMA(0, 0, At, B0); PG8_MMA(0, 1, At, B1); PG8_BAR; PG8_SCHED;
      PG8_LDA(At, 1, 1); PG8_STAGE(PG8_SB(1, 0), b3, voffB); PG8_STAGE(PG8_SB(1, 1), b3 + hstepB, voffB); PG8_STAGE(PG8_SA(1, 0), a3, voffA);
      PG8_WAIT_V(8); PG8_WAIT_L(0); PG8_BAR; PG8_MMA(1, 0, At, B0); PG8_MMA(1, 1, At, B1); PG8_BAR; PG8_SCHED;
    }
    if (wr == 0) PG8_BAR;
    E(acc, cur, wr, wc, fr, fq);
    if (!has_next) break;
    bool carry = false;
    if constexpr (Epi::KEEPS) carry = E.keep(cur);
    if (!carry) {
#pragma unroll
    for (int a = 0; a < 2; ++a)
#pragma unroll
      for (int b = 0; b < 2; ++b)
#pragma unroll
        for (int m = 0; m < 4; ++m)
#pragma unroll
          for (int n = 0; n < 2; ++n) acc[a][b][m][n] = (f32x4){0.f, 0.f, 0.f, 0.f};
    }
    cur = nxt; cA = nA; cB = nB; ++ui;
    if (wr == 1) PG8_BAR;
  }
  PG8_WAIT_V(0);
  PG8_BAR;
#undef PG8_SA
#undef PG8_SB
#undef PG8_STAGE
#undef PG8_LDA
#undef PG8_LDB
#undef PG8_MMA
#undef PG8_WAIT_V
#undef PG8_WAIT_L
#undef PG8_BAR
#undef PG8_SCHED
}

template <class F> DI void epi_each(const f32x4 (&acc)[2][2][4][2], int wr, int wc, int fr, int fq, F f) {
  asm volatile("" : "+v"(fr), "+v"(fq));
#pragma unroll
  for (int ai = 0; ai < 2; ++ai)
#pragma unroll
    for (int m = 0; m < 4; ++m) { const int row = ai * HALF + wr * 64 + m * 16 + fr;
#pragma unroll
      for (int bj = 0; bj < 2; ++bj) { const int col = bj * HALF + wc * 32 + 8 * fq; f(row, col, acc[ai][bj][m][0], acc[ai][bj][m][1]); } }
}
DI u32x4 pk8(const f32x4 a, const f32x4 b) { u32x4 w; w.x = cvt_pk(a[0], a[1]); w.y = cvt_pk(a[2], a[3]); w.z = cvt_pk(b[0], b[1]); w.w = cvt_pk(b[2], b[3]); return w; }

__host__ __device__ __forceinline__ bool g1a_perm_tile(int pn) { return pn < 10 || pn == 12 || pn == 13 || (pn >= 16 && pn <= 22); }
struct EpiG1a {
  static constexpr bool KEEPS = false;
  bf16_t* QBp; bf16_t* KVBp; const float* a_qn; const float* c_qn; const float* d_qn; const float* a_kn; const float* c_kn; const float* d_kn;
  DI void operator()(const f32x4 (&acc)[2][2][4][2], const Unit& u, int wr, int wc, int fr, int fq) const {
    bf16_t* base; int ld; const int pn = u.pn;
    if (pn < 12) { base = QBp + pn * BM; ld = PQ; } else { base = KVBp + (pn - 12) * BM; ld = PKV; }
    base += (size_t)u.pm * BM * ld;
    if (!g1a_perm_tile(pn)) {
      epi_each(acc, wr, wc, fr, fq, [&](int row, int col, const f32x4 v0, const f32x4 v1) { *(u32x4*)(base + (size_t)row * ld + col) = pk8(v0, v1); });
      return;
    }
    asm volatile("" : "+v"(fr), "+v"(fq));
    const float* gp; float post = 1.0f; bool norm = true;
    if (pn < 2) { gp = a_qn; post = 0.125f * LOG2E; } else if (pn < 4) { gp = c_qn; post = 0.125f * LOG2E; } else if (pn < 10) { gp = d_qn; post = 0.125f * LOG2E; }
    else if (pn < 14) gp = a_kn; else if (pn == 16) { gp = c_kn; norm = wc < 2; } else gp = d_kn;
    const f32x4 g00 = *(const f32x4*)(gp + 8 * fq), g01 = *(const f32x4*)(gp + 8 * fq + 4), g10 = *(const f32x4*)(gp + 32 + 8 * fq), g11 = *(const f32x4*)(gp + 32 + 8 * fq + 4);
#pragma unroll
    for (int ai = 0; ai < 2; ++ai)
#pragma unroll
      for (int m = 0; m < 4; ++m) {
        const int row = ai * HALF + wr * 64 + m * 16 + fr;
        f32x4 v00 = acc[ai][0][m][0], v01 = acc[ai][0][m][1], v10 = acc[ai][1][m][0], v11 = acc[ai][1][m][1];
        float ss = 0.f;
#pragma unroll
        for (int j = 0; j < 4; ++j) ss += v00[j] * v00[j] + v01[j] * v01[j] + v10[j] * v10[j] + v11[j] * v11[j];
        ss += __shfl_xor(ss, 16); ss += __shfl_xor(ss, 32);
        if (norm) { const float r = rsqrtf(ss * (1.0f / 64.0f) + EPS) * post; v00 = v00 * r * g00; v01 = v01 * r * g01; v10 = v10 * r * g10; v11 = v11 * r * g11; }
        bf16_t* p = base + (size_t)row * ld + wc * 64 + 8 * fq;
        *(u32x4*)p = pk8(v00, v01); *(u32x4*)(p + 32) = pk8(v10, v11);
      }
  }
};
struct EpiPlain {
  static constexpr bool KEEPS = false;
  bf16_t* C; int ldc;
  DI void operator()(const f32x4 (&acc)[2][2][4][2], const Unit& u, int wr, int wc, int fr, int fq) const {
    bf16_t* base = C + (size_t)u.pm * BM * ldc + u.pn * BM;
    epi_each(acc, wr, wc, fr, fq, [&](int row, int col, const f32x4 v0, const f32x4 v1) { *(u32x4*)(base + (size_t)row * ldc + col) = pk8(v0, v1); });
  }
};
struct EpiGate {
  static constexpr bool KEEPS = false;
  bf16_t* C; const float* bias;
  DI void operator()(const f32x4 (&acc)[2][2][4][2], const Unit& u, int wr, int wc, int fr, int fq) const {
    bf16_t* base = C + (size_t)u.pm * BM * PGATE + u.pn * BM; const float* bb = bias + u.pn * BM;
    epi_each(acc, wr, wc, fr, fq, [&](int row, int col, f32x4 v0, f32x4 v1) {
      const f32x4 b0 = *(const f32x4*)(bb + col), b1 = *(const f32x4*)(bb + col + 4);
#pragma unroll
      for (int j = 0; j < 4; ++j) { v0[j] = sigmoidf_(v0[j] + b0[j]); v1[j] = sigmoidf_(v1[j] + b1[j]); }
      *(u32x4*)(base + (size_t)row * PGATE + col) = pk8(v0, v1); });
  }
};
struct EpiZ {
  static constexpr bool KEEPS = false;
  bf16_t* QBp;
  DI void operator()(const f32x4 (&acc)[2][2][4][2], const Unit& u, int wr, int wc, int fr, int fq) const {
    const int br = u.pn >> 1; const int ocol = (br == 0 ? QC_OA : br == 1 ? QC_OB : br == 2 ? QC_CQ : br == 3 ? QC_DQ : QC_MQ) + (u.pn & 1) * BM;
    bf16_t* base = QBp + (size_t)u.pm * BM * PQ + ocol;
    epi_each(acc, wr, wc, fr, fq, [&](int row, int col, f32x4 v0, f32x4 v1) {
      bf16_t* p = base + (size_t)row * PQ + col; float o[8]; unpack8(*(const u32x4*)p, o);
#pragma unroll
      for (int j = 0; j < 4; ++j) { v0[j] = o[j] * v0[j] * sigmoidf_(v0[j]); v1[j] = o[4 + j] * v1[j] * sigmoidf_(v1[j]); }
      *(u32x4*)p = pk8(v0, v1); });
  }
};
struct EpiMerge {
  static constexpr bool KEEPS = true;
  bf16_t* ACC; const bf16_t* GATEp; int bmask;
  DI bool keep(const Unit& u) const { return u.aux < 4; }
  DI void operator()(f32x4 (&acc)[2][2][4][2], const Unit& u, int wr, int wc, int fr, int fq) const {
    asm volatile("" : "+v"(fr), "+v"(fq));
    const int br = u.aux;
    bf16_t* base = ACC + (size_t)u.pm * BM * DM + u.pn * BM; const bf16_t* gb = GATEp + (size_t)u.pm * BM * PGATE + br * 1024 + u.pn * BM;
#pragma unroll
    for (int ai = 0; ai < 2; ++ai)
#pragma unroll
      for (int m = 0; m < 4; ++m) { const int row = ai * HALF + wr * 64 + m * 16 + fr;
#pragma unroll
        for (int bj = 0; bj < 2; ++bj) { const int col = bj * HALF + wc * 32 + 8 * fq;
          float g0[8]; unpack8(*(const u32x4*)(gb + (size_t)row * PGATE + col), g0);
          if (br < 4) { float g1[8]; unpack8(*(const u32x4*)(gb + 1024 + (size_t)row * PGATE + col), g1);
#pragma unroll
            for (int j = 0; j < 4; ++j) { acc[ai][bj][m][0][j] *= g0[j] * __builtin_amdgcn_rcpf(fmaxf(g1[j], 1e-20f)); acc[ai][bj][m][1][j] *= g0[4 + j] * __builtin_amdgcn_rcpf(fmaxf(g1[4 + j], 1e-20f)); }
          } else { f32x4 v0 = acc[ai][bj][m][0], v1 = acc[ai][bj][m][1];
#pragma unroll
            for (int j = 0; j < 4; ++j) { v0[j] *= g0[j]; v1[j] *= g0[4 + j]; }
            *(u32x4*)(base + (size_t)row * DM + col) = pk8(v0, v1); } } }
  }
};
struct EpiOut {
  static constexpr bool KEEPS = false;
  const float* X; float* Y;
  DI void operator()(const f32x4 (&acc)[2][2][4][2], const Unit& u, int wr, int wc, int fr, int fq) const {
    const size_t off = (size_t)u.pm * BM * DM + u.pn * BM;
    epi_each(acc, wr, wc, fr, fq, [&](int row, int col, const f32x4 v0, const f32x4 v1) {
      const size_t o = off + (size_t)row * DM + col; const f32x4 x0 = *(const f32x4*)(X + o), x1 = *(const f32x4*)(X + o + 4);
      *(f32x4*)(Y + o) = x0 + v0; *(f32x4*)(Y + o + 4) = x1 + v1; });
  }
};
}

DI void grid_sync() {
  __builtin_amdgcn_fence(__ATOMIC_RELEASE, "agent");
  asm volatile("s_waitcnt vmcnt(0)" ::: "memory");
  cg::this_grid().sync();
  __builtin_amdgcn_fence(__ATOMIC_ACQUIRE, "agent");
  asm volatile("s_waitcnt vmcnt(0)" ::: "memory");
}

#define XB_TMO      128
#define XB_XCNT(j)  (256  + 64 * (j))
#define XB_XSUB(j)  (1280 + 64 * (j))
#define XB_XGEN(j)  (2304 + 64 * (j))
#define XB_TOP      3328
#define XB_TOPGEN   3392
#define XCD_BAR_WORDS 3456
#define XB_SPIN_CAP (1u << 22)
DI unsigned xb_ld(unsigned* p)              { return __hip_atomic_load(p, __ATOMIC_RELAXED, __HIP_MEMORY_SCOPE_AGENT); }
DI unsigned xb_add(unsigned* p, unsigned v) { return __hip_atomic_fetch_add(p, v, __ATOMIC_RELAXED, __HIP_MEMORY_SCOPE_AGENT); }
DI unsigned xb_xcc_id() { return (unsigned)__builtin_amdgcn_s_getreg((3 << 11) | 20) & 0xFu; }
#define XB_SPIN(cond, bar) do { unsigned _sp = 0; while (cond) { __builtin_amdgcn_s_sleep(1); \
    if ((++_sp & 255u) == 0u) { if (xb_ld(&(bar)[XB_TMO])) break; if (_sp > XB_SPIN_CAP) { atomicAdd(&(bar)[XB_TMO], 1u); break; } } } } while (0)
struct XcdBarrier { unsigned* bar; unsigned x; volatile LAS unsigned* st; };
DI XcdBarrier xcd_barrier_post(unsigned* bar, volatile LAS unsigned* st) {
  XcdBarrier b; b.bar = bar; b.x = xb_xcc_id(); b.st = st;
  if (threadIdx.x == 0) (void)xb_add(&bar[XB_XCNT(b.x)], 1u);
  return b;
}
DI void xcd_barrier_complete(unsigned* bar, unsigned x, unsigned& nloc, unsigned& nx) {
  const unsigned G = gridDim.x * gridDim.y * gridDim.z;
  unsigned sum, cnt, mine, sp = 0u;
  for (;;) {
    sum = 0u; cnt = 0u; mine = 0u;
#pragma unroll
    for (unsigned j = 0; j < 16; ++j) { const unsigned c = xb_ld(&bar[XB_XCNT(j)]); sum += c; cnt += (c > 0u) ? 1u : 0u; mine = (j == x) ? c : mine; }
    if (sum == G) break;
    __builtin_amdgcn_s_sleep(1);
    if ((++sp & 255u) == 0u) { if (xb_ld(&bar[XB_TMO])) break; if (sp > XB_SPIN_CAP) { atomicAdd(&bar[XB_TMO], 1u); break; } }
  }
  nloc = mine > 0u ? mine : 1u; nx = cnt > 0u ? cnt : 1u;
}
DI void xcd_barrier(const XcdBarrier& b) {
  asm volatile("s_waitcnt vmcnt(0)" ::: "memory");
  __syncthreads();
  if (threadIdx.x == 0) {
    unsigned* bar = b.bar;
    __builtin_amdgcn_s_waitcnt(0);
    unsigned nloc = b.st[0], nx = b.st[1];
    if (nloc == 0u) { xcd_barrier_complete(bar, b.x, nloc, nx); b.st[0] = nloc; b.st[1] = nx; }
    const unsigned old = xb_add(&bar[XB_XSUB(b.x)], 1u);
    const unsigned gen = old / nloc;
    if (old + 1u == (gen + 1u) * nloc) {
      __builtin_amdgcn_fence(__ATOMIC_RELEASE, "agent");
      asm volatile("s_waitcnt vmcnt(0)" ::: "memory");
      const unsigned og = xb_add(&bar[XB_TOP], 1u);
      const unsigned tg = og / nx;
      if (og + 1u == (tg + 1u) * nx) xb_add(&bar[XB_TOPGEN], 1u);
      else XB_SPIN(xb_ld(&bar[XB_TOPGEN]) == tg, bar);
      __builtin_amdgcn_fence(__ATOMIC_ACQUIRE, "agent");
      xb_add(&bar[XB_XGEN(b.x)], 1u);
      asm volatile("s_waitcnt vmcnt(0)" ::: "memory");
    } else {
      XB_SPIN(xb_ld(&bar[XB_XGEN(b.x)]) == gen, bar);
      __builtin_amdgcn_fence(__ATOMIC_ACQUIRE, "agent");
      asm volatile("s_waitcnt vmcnt(0)" ::: "memory");
    }
  }
  __syncthreads();
}
template <class F>
DI void tconv(LAS float* tile, bf16_t* dst, int ldd, int Nd, int K, F f, int cu, int ncu) {
  int tid = threadIdx.x; asm volatile("" : "+v"(tid)); const int ntk = K / 64, ntot = (Nd / 64) * ntk;
  for (int t = cu; t < ntot; t += ncu) {
    const int n0 = (t / ntk) * 64, k0 = (t % ntk) * 64;
#pragma unroll
    for (int i = 0; i < 8; ++i) { const int e = tid + i * 512, kk = e >> 6, nn = e & 63; tile[kk * 65 + nn] = f(k0 + kk, n0 + nn); }
    __syncthreads();
    { const int n = tid >> 3, kc = (tid & 7) * 8; float v[8];
#pragma unroll
      for (int j = 0; j < 8; ++j) v[j] = tile[(kc + j) * 65 + n];
      *(u32x4*)(dst + (size_t)(n0 + n) * ldd + k0 + kc) = pack8(v); }
    __syncthreads();
  }
}
DI int win_src(int n) {
  if (n < NG1 && pg8::g1a_perm_tile(n >> 8)) { const int ct = n & 255; n = (n & ~255) + ((ct >> 5) & 3) * 64 + (ct >> 7) * 32 + (ct & 31); }
  if (n < 3072) { if (n < 512) return n; if (n < 1024) return 1952 + (n - 512); if (n < 2560) return 2720 + (n - 1024); return 7328 + (n - 2560); }
  if (n < NG1) { const int c = n - 3072;
    if (c < 512) return 512 + c; if (c < 1024) return 1024 + (c - 512); if (c < 1152) return 2464 + (c - 1024); if (c < 1280) return 2592 + (c - 1152);
    if (c < 2816) return 4256 + (c - 1280); if (c < 4352) return 5792 + (c - 2816); if (c < 4608) return 1536 + (c - 4352); if (c < 4736) return 1792 + (c - 4608);
    if (c < 4768) return 1920 + (c - 4736); return -1; }
  return 7840 + (n - NG1);
}

DI u32x4 ldraw(const bf16_t* src, bool act) { u32x4 raw = (u32x4){0u, 0u, 0u, 0u}; if (act) raw = *(const u32x4*)src; return raw; }
template <int LPH>
DI void seg_norm(const bf16_t* src, bf16_t* dst, bool act, const float* gain, float post, float* vout, const u32x4* pre = nullptr, float inscale = 1.0f) {
  float v[8]; u32x4 raw; if (pre) raw = *pre; else raw = ldraw(src, act); unpack8(raw, v);
#pragma unroll
  for (int i = 0; i < 8; ++i) v[i] *= inscale;
  float ss = 0.f;
#pragma unroll
  for (int i = 0; i < 8; ++i) ss += v[i] * v[i];
#pragma unroll
  for (int o = 1; o < LPH; o <<= 1) ss += __shfl_xor(ss, o);
  const float r = rsqrtf(ss * (1.0f / (LPH * 8)) + EPS) * post;
#pragma unroll
  for (int i = 0; i < 8; ++i) v[i] = v[i] * r * (act ? gain[i] : 0.f);
  if (vout) {
#pragma unroll
    for (int i = 0; i < 8; ++i) vout[i] = v[i];
  } else if (act) *(u32x4*)dst = pack8(v);
}
DI void rope4(float* v, int lane4, const float* cs  , const float* sn  ) {
  const int jb = (lane4 & 1) * 8;
#pragma unroll
  for (int i = 0; i < 8; ++i) {
    const float partner = __shfl_xor(v[i], 2);
    const float c = cs[jb + i], s = sn[jb + i];
    v[i] = (lane4 < 2) ? (v[i] * c - partner * s) : (v[i] * c + partner * s);
  }
}


#define AT_SB __builtin_amdgcn_sched_barrier(0)
template <int NS, int KP>
DI void attn_qk(f32x16 (&st)[2], const bf16x8 (&qf)[NS], const LAS unsigned char* kbl  ) {
#pragma unroll
  for (int i = 0; i < 16; ++i) { st[0][i] = 0.f; st[1][i] = 0.f; }
  bf16x8 a0 = *(const LAS bf16x8*)(kbl), a1 = *(const LAS bf16x8*)(kbl + 32 * KP);
#pragma unroll
  for (int s = 0; s < NS; ++s) {
    bf16x8 n0 = a0, n1 = a1;
    if (s + 1 < NS) { n0 = *(const LAS bf16x8*)(kbl + 32 * (s + 1)); n1 = *(const LAS bf16x8*)(kbl + 32 * KP + 32 * (s + 1)); }
    AT_SB;
    st[0] = __builtin_amdgcn_mfma_f32_32x32x16_bf16(a0, qf[s], st[0], 0, 0, 0);
    st[1] = __builtin_amdgcn_mfma_f32_32x32x16_bf16(a1, qf[s], st[1], 0, 0, 0);
    AT_SB;
    a0 = n0; a1 = n1;
  }
}
template <int NDV, int VP>
DI void attn_pv_load0(s16x4 (&l0)[NDV], s16x4 (&h0)[NDV], LAS unsigned char* vbl) {
#pragma unroll
  for (int d = 0; d < NDV; ++d) {
    l0[d] = __builtin_bit_cast(s16x4, __builtin_amdgcn_ds_read_tr16_b64_v4i16((LAS s16x4*)(vbl + d * 64)));
    h0[d] = __builtin_bit_cast(s16x4, __builtin_amdgcn_ds_read_tr16_b64_v4i16((LAS s16x4*)(vbl + 8 * VP + d * 64))); }
}
template <int NDV, int VP, bool PRE>
DI void attn_pv(f32x16 (&o)[NDV], const u32x4 (&pfw)[4], LAS unsigned char* vbl  , s16x4 (&l0)[NDV], s16x4 (&h0)[NDV]) {
  s16x4 l1[NDV], h1[NDV];
#define AT_LD(l, h, b) _Pragma("unroll") for (int d = 0; d < NDV; ++d) { \
    l[d] = __builtin_bit_cast(s16x4, __builtin_amdgcn_ds_read_tr16_b64_v4i16((LAS s16x4*)(vbl + (16 * (b)) * VP + d * 64))); \
    h[d] = __builtin_bit_cast(s16x4, __builtin_amdgcn_ds_read_tr16_b64_v4i16((LAS s16x4*)(vbl + (16 * (b) + 8) * VP + d * 64))); }
#define AT_MM(l, h, b) { const bf16x8 _pf = __builtin_bit_cast(bf16x8, pfw[b]); _Pragma("unroll") for (int d = 0; d < NDV; ++d) \
    o[d] = __builtin_amdgcn_mfma_f32_32x32x16_bf16(__builtin_shufflevector(l[d], h[d], 0, 1, 2, 3, 4, 5, 6, 7), _pf, o[d], 0, 0, 0); }
  if (!PRE) { AT_LD(l0, h0, 0); }
  AT_LD(l1, h1, 1); AT_SB; AT_MM(l0, h0, 0); AT_SB;
  AT_LD(l0, h0, 2); AT_SB; AT_MM(l1, h1, 1); AT_SB;
  AT_LD(l1, h1, 3); AT_SB; AT_MM(l0, h0, 2); AT_SB;
  AT_MM(l1, h1, 3); AT_SB;
#undef AT_LD
#undef AT_MM
}
template <int NS, int KP>
DI void attn_qk1(f32x16& st, const bf16x8 (&qf)[NS], const LAS unsigned char* kbl  ) {
#pragma unroll
  for (int i = 0; i < 16; ++i) st[i] = 0.f;
  bf16x8 a0 = *(const LAS bf16x8*)(kbl), a1 = *(const LAS bf16x8*)(kbl + 32);
#pragma unroll
  for (int s = 0; s < NS; ++s) {
    bf16x8 n = a1;
    if (s + 2 < NS) n = *(const LAS bf16x8*)(kbl + 32 * (s + 2));
    AT_SB;
    st = __builtin_amdgcn_mfma_f32_32x32x16_bf16(a0, qf[s], st, 0, 0, 0);
    AT_SB;
    a0 = a1; a1 = n;
  }
}
template <int NDV, int VP, bool PRE>
DI void attn_pv2(f32x16 (&o)[NDV], const u32x4& p0, const u32x4& p1, LAS unsigned char* vbl  , s16x4 (&l0)[NDV], s16x4 (&h0)[NDV]) {
  s16x4 l1[NDV], h1[NDV];
  if (!PRE) {
#pragma unroll
    for (int d = 0; d < NDV; ++d) { l0[d] = __builtin_bit_cast(s16x4, __builtin_amdgcn_ds_read_tr16_b64_v4i16((LAS s16x4*)(vbl + d * 64)));
      h0[d] = __builtin_bit_cast(s16x4, __builtin_amdgcn_ds_read_tr16_b64_v4i16((LAS s16x4*)(vbl + 8 * VP + d * 64))); } }
#pragma unroll
  for (int d = 0; d < NDV; ++d) { l1[d] = __builtin_bit_cast(s16x4, __builtin_amdgcn_ds_read_tr16_b64_v4i16((LAS s16x4*)(vbl + 16 * VP + d * 64)));
    h1[d] = __builtin_bit_cast(s16x4, __builtin_amdgcn_ds_read_tr16_b64_v4i16((LAS s16x4*)(vbl + 24 * VP + d * 64))); }
  AT_SB;
  { const bf16x8 pf = __builtin_bit_cast(bf16x8, p0);
#pragma unroll
    for (int d = 0; d < NDV; ++d) o[d] = __builtin_amdgcn_mfma_f32_32x32x16_bf16(__builtin_shufflevector(l0[d], h0[d], 0, 1, 2, 3, 4, 5, 6, 7), pf, o[d], 0, 0, 0); }
  AT_SB;
  { const bf16x8 pf = __builtin_bit_cast(bf16x8, p1);
#pragma unroll
    for (int d = 0; d < NDV; ++d) o[d] = __builtin_amdgcn_mfma_f32_32x32x16_bf16(__builtin_shufflevector(l1[d], h1[d], 0, 1, 2, 3, 4, 5, 6, 7), pf, o[d], 0, 0, 0); }
  AT_SB;
}
template <int DQK, int DV, bool BIAS, bool MASK, bool BMM>
DI void attn_item(LAS unsigned char* lds, const bf16_t* Q, int pq, const bf16_t* K, int pk, const bf16_t* V, int pv, bf16_t* O, int po,
                  float* lse, int lse_stride, int q0, int L, int W, float slope2, float m_init, float l_init) {
  constexpr int KP = DQK * 2 + 16, VP = DV * 2 + 64, KBYTES = 64 * KP, VBYTES = 64 * VP, BUF = KBYTES + VBYTES;
  constexpr int KC8 = DQK / 8, VC8 = DV / 8, KCH = 64 * KC8, VCH = 64 * VC8, KPT = (KCH + 511) / 512, VPT = (VCH + 511) / 512;
  constexpr int NS = DQK / 16, NDV = DV / 32;
  int tid = threadIdx.x; asm volatile("" : "+v"(tid));
  const int wid = tid >> 6, lane = tid & 63, r = lane & 31, h = lane >> 5;
  const int qw0 = q0 + 32 * wid, qi = qw0 + r;
  bf16x8 qf[NS];
#pragma unroll
  for (int s = 0; s < NS; ++s) qf[s] = *(const bf16x8*)(Q + (size_t)qi * pq + 16 * s + 8 * h);
  f32x16 o[NDV];
#pragma unroll
  for (int d = 0; d < NDV; ++d)
#pragma unroll
    for (int i = 0; i < 16; ++i) o[d][i] = 0.f;
  float m = m_init, lsum = (h == 0) ? l_init : 0.f;
  u32x4 kext[2]; unsigned cw1 = 0u, cw2 = 0u;
  if (BMM) {
    const unsigned one = 0x3F80u;
#pragma unroll
    for (int b2 = 0; b2 < 2; ++b2) { const unsigned jb = cvt_pk((float)(32 * b2 + r), 0.f) & 0xffffu;
      kext[b2] = (h == 0) ? (u32x4){one | (one << 16), one | (jb << 16), jb | (jb << 16), 0u} : (u32x4){0u, 0u, 0u, 0u}; }
    const unsigned c_hi = cvt_pk(slope2, 0.f) & 0xffffu; const float r1 = slope2 - __uint_as_float(c_hi << 16);
    const unsigned c_mid = cvt_pk(r1, 0.f) & 0xffffu; const float r2 = r1 - __uint_as_float(c_mid << 16); const unsigned c_lo = cvt_pk(r2, 0.f) & 0xffffu;
    cw1 = c_hi << 16; cw2 = c_mid | (c_lo << 16);
  }
  const int klo = (q0 - W > 0 ? q0 - W : 0) >> 6;
  const int khi = ((q0 + 256 + W < L ? q0 + 256 + W : L) + 63) >> 6;
  const int nt = khi - klo;
  u32x4 kreg[KPT], vreg[VPT];
#define AT_GLOAD(kt) do { const int _k0 = (kt) * 64; \
    _Pragma("unroll") for (int _i = 0; _i < KPT; ++_i) { const int _c = tid + _i * 512; if (_c < KCH) { const int _row = _c / KC8, _cc = _c - _row * KC8; kreg[_i] = *(const u32x4*)(K + (size_t)(_k0 + _row) * pk + _cc * 8); } } \
    _Pragma("unroll") for (int _i = 0; _i < VPT; ++_i) { const int _c = tid + _i * 512; if (_c < VCH) { const int _row = _c / VC8, _cc = _c - _row * VC8; vreg[_i] = *(const u32x4*)(V + (size_t)(_k0 + _row) * pv + _cc * 8); } } } while (0)
#define AT_LSTORE(ks, vs_) do { LAS unsigned char* _kb = lds + (ks) * KBYTES; LAS unsigned char* _vb = lds + 2 * KBYTES + (vs_) * VBYTES; \
    _Pragma("unroll") for (int _i = 0; _i < KPT; ++_i) { const int _c = tid + _i * 512; if (_c < KCH) { const int _row = _c / KC8, _cc = _c - _row * KC8; *(LAS u32x4*)(_kb + _row * KP + _cc * 16) = kreg[_i]; } } \
    _Pragma("unroll") for (int _i = 0; _i < VPT; ++_i) { const int _c = tid + _i * 512; if (_c < VCH) { const int _row = _c / VC8, _cc = _c - _row * VC8; *(LAS u32x4*)(_vb + _row * VP + _cc * 16) = vreg[_i]; } } } while (0)
#define AT_PV(vstage) do { s16x4 _l0[NDV], _h0[NDV]; attn_pv<NDV, VP, false>(o, pfw, lds + 2 * KBYTES + (vstage) * VBYTES + vlane_off, _l0, _h0); } while (0)
  AT_GLOAD(klo); AT_LSTORE(0, 0); __syncthreads();
  const int i16 = lane & 15, q4 = i16 >> 2, p4 = i16 & 3, blk = (lane >> 4) & 1;
  const int vlane_off = (4 * h + q4) * VP + (16 * blk + 4 * p4) * 2;
  const bool lag = wid >= 4;
  u32x4 pfw[4]; bool pend = false; int pend_vs = 0, vs = 0;
#pragma unroll
  for (int i = 0; i < 4; ++i) pfw[i] = (u32x4){0u, 0u, 0u, 0u};
  for (int t = 0; t < nt; ++t) {
    const int k0 = (klo + t) * 64;
    if (t + 1 < nt) AT_GLOAD(klo + t + 1);
    const bool active = (k0 + 63 >= qw0 - W) && (k0 <= qw0 + 31 + W);
    if (pend) { AT_PV(pend_vs); pend = false; }
    if (active) {
      LAS unsigned char* kb = lds + (t & 1) * KBYTES;
      f32x16 st[2];
      const int side = !BMM ? 0 : (k0 + 63 < qw0) ? 1 : (k0 > qw0 + 31) ? -1 : 0;
      bf16x8 qeb = qf[0];
      if (BMM && side != 0) {
        const float av = (side > 0 ? -slope2 : slope2) * (float)(qi - k0);
        const unsigned a_hi = cvt_pk(av, 0.f) & 0xffffu; const float q1 = av - __uint_as_float(a_hi << 16);
        const unsigned a_mid = cvt_pk(q1, 0.f) & 0xffffu; const float q2 = q1 - __uint_as_float(a_mid << 16); const unsigned a_lo = cvt_pk(q2, 0.f) & 0xffffu;
        const unsigned sg = side > 0 ? 0u : 0x80008000u;
        const u32x4 qe = {a_hi | (a_mid << 16), a_lo | ((cw1 ^ sg) & 0xffff0000u), cw2 ^ sg, 0u};
        qeb = __builtin_bit_cast(bf16x8, qe);
      }
      attn_qk<NS, KP>(st, qf, kb + r * KP + 16 * h);
      if (BMM && side != 0) { st[0] = __builtin_amdgcn_mfma_f32_32x32x16_bf16(__builtin_bit_cast(bf16x8, kext[0]), qeb, st[0], 0, 0, 0);
        st[1] = __builtin_amdgcn_mfma_f32_32x32x16_bf16(__builtin_bit_cast(bf16x8, kext[1]), qeb, st[1], 0, 0, 0); }
      AT_SB;
      LAS unsigned char* vbase = lds + 2 * KBYTES + vs * VBYTES + vlane_off;
      s16x4 vl0[NDV], vh0[NDV];
      if (!lag) attn_pv_load0<NDV, VP>(vl0, vh0, vbase);
#define AT_SM(b2) do { \
      if ((BIAS || MASK) && !(BMM && side != 0)) { const float basef = (float)(qi - k0 - 4 * h), Wf = (float)W; \
        _Pragma("unroll") for (int i = 0; i < 16; ++i) { float s = st[b2][i]; const float df = basef - (float)(32 * (b2) + (i & 3) + 8 * (i >> 2)); \
          if (BIAS) s = s - slope2 * fabsf(df); if (MASK) s = (fabsf(df) > Wf) ? -INFINITY : s; st[b2][i] = s; } } \
      float ps = 0.f; \
      _Pragma("unroll") for (int i = 0; i < 16; ++i) { const float p = fexp2(st[b2][i]); st[b2][i] = p; ps += p; } \
      lsum += ps; \
      _Pragma("unroll") for (int s2 = 0; s2 < 2; ++s2) { u32x4 pw; pw.x = cvt_pk(st[b2][8 * s2 + 0], st[b2][8 * s2 + 1]); pw.y = cvt_pk(st[b2][8 * s2 + 2], st[b2][8 * s2 + 3]); \
        pw.z = cvt_pk(st[b2][8 * s2 + 4], st[b2][8 * s2 + 5]); pw.w = cvt_pk(st[b2][8 * s2 + 6], st[b2][8 * s2 + 7]); pfw[(b2) * 2 + s2] = pw; } } while (0)
      AT_SM(0);
      if (!lag) attn_pv2<NDV, VP, true>(o, pfw[0], pfw[1], vbase, vl0, vh0);
      AT_SM(1);
      if (lag) { pend = true; pend_vs = vs; } else { s16x4 vl2[NDV], vh2[NDV]; attn_pv2<NDV, VP, false>(o, pfw[2], pfw[3], vbase + 32 * VP, vl2, vh2); }
#undef AT_SM
    }
    const int vsn = vs == 2 ? 0 : vs + 1;
    if (t + 1 < nt) AT_LSTORE((t + 1) & 1, vsn);
    __syncthreads();
    vs = vsn;
  }
  if (pend) { AT_PV(pend_vs); }
#undef AT_PV
#undef AT_GLOAD
#undef AT_LSTORE
  const float lt = lsum + __shfl_xor(lsum, 32); const float inv = 1.0f / lt;
#pragma unroll
  for (int d = 0; d < NDV; ++d)
#pragma unroll
    for (int g4 = 0; g4 < 4; ++g4) {
      u32x2 w; w.x = cvt_pk(o[d][4 * g4] * inv, o[d][4 * g4 + 1] * inv); w.y = cvt_pk(o[d][4 * g4 + 2] * inv, o[d][4 * g4 + 3] * inv);
      *(u32x2*)(O + (size_t)qi * po + 32 * d + 8 * g4 + 4 * h) = w;
    }
  if (lse != nullptr && h == 0) lse[(size_t)qi * lse_stride] = m + __log2f(lt);
}


#ifdef DBG
#define WS_DBG (512 * 1024)
DI void dbg_max(unsigned* p, float e) { if (!(e >= 0.f)) e = 1e9f; atomicMax(p, __float_as_uint(e)); }
DI unsigned dbg_hash(unsigned x) { x ^= x >> 16; x *= 0x7feb352du; x ^= x >> 15; x *= 0x846ca68bu; x ^= x >> 16; return x; }
template <int DQK, int DV>
DI float dbg_attn_row(LAS float* sc, const bf16_t* Q, int pq, const bf16_t* K, int pk, const bf16_t* V, int pv, const bf16_t* O, int po,
                      int qi, int L, int W, float slope2, float m_init, float l_init, int lane) {
  float mx = m_init;
  for (int j = lane; j < L; j += 64) {
    int d = qi - j; d = d < 0 ? -d : d; float s = -INFINITY;
    if (d <= W) { s = 0.f; for (int c = 0; c < DQK; ++c) s += bf2f(Q[(size_t)qi * pq + c]) * bf2f(K[(size_t)j * pk + c]); s -= slope2 * (float)d; }
    sc[j] = s; mx = fmaxf(mx, s);
  }
  for (int o = 1; o < 64; o <<= 1) mx = fmaxf(mx, __shfl_xor(mx, o));
  float sum = 0.f;
  for (int j = lane; j < L; j += 64) { const float p = exp2f(sc[j] - mx); sc[j] = p; sum += p; }
  for (int o = 1; o < 64; o <<= 1) sum += __shfl_xor(sum, o);
  sum += l_init * exp2f(m_init - mx);
  float emax = 0.f, rmax = 0.f;
  for (int dv = lane; dv < DV; dv += 64) {
    float acc = 0.f; for (int j = 0; j < L; ++j) acc += sc[j] * bf2f(V[(size_t)j * pv + dv]);
    acc /= sum; const float got = bf2f(O[(size_t)qi * po + dv]);
    emax = fmaxf(emax, fabsf(got - acc)); rmax = fmaxf(rmax, fabsf(acc));
  }
  for (int o = 1; o < 64; o <<= 1) { emax = fmaxf(emax, __shfl_xor(emax, o)); rmax = fmaxf(rmax, __shfl_xor(rmax, o)); }
  return emax / (rmax + 1e-3f);
}
#endif
#define WSP(T, off) ((T*)(ap->ws + (off)))
#define ROPE WSP(float, WS_ROPE)
#define WIN WSP(bf16_t, WS_WIN)
#define WMLA WSP(bf16_t, WS_WMLA)
#define WMEM WSP(bf16_t, WS_WMEM)
#define WBR WSP(bf16_t, WS_WBR)
#define WOUT WSP(bf16_t, WS_WOUT)
#define MN WSP(bf16_t, WS_MN)
#define MKV WSP(bf16_t, WS_MKV)
#define LSE WSP(float, WS_LSE)
#define H WSP(bf16_t, WS_H)
#define QB WSP(bf16_t, WS_QB)
#define KVB WSP(bf16_t, WS_KVB)
#define MLA WSP(bf16_t, WS_MLA)
#define BK WSP(bf16_t, WS_BK)
#define GATE WSP(bf16_t, WS_GATE)
typedef const __attribute__((address_space(4))) Args* CArgsP;
__global__ void __launch_bounds__(512, 2) mega(Args args_unused) {
  extern __shared__ __attribute__((aligned(16))) unsigned char shm_raw[];
  LAS unsigned char* lds = (LAS unsigned char*)shm_raw;
  const int ph_lo = ((CArgsP)__builtin_amdgcn_kernarg_segment_ptr())->ph_lo, ph_hi = ((CArgsP)__builtin_amdgcn_kernarg_segment_ptr())->ph_hi;
  volatile LAS unsigned* xb_st = (volatile LAS unsigned*)(lds + 131072);
  if (threadIdx.x == 0) { xb_st[0] = 0u; xb_st[1] = 0u; }
  __syncthreads();
  const XcdBarrier xbar = xcd_barrier_post((unsigned*)(((CArgsP)__builtin_amdgcn_kernarg_segment_ptr())->ws), xb_st);
  for (int ph = ph_lo; ph < ph_hi; ++ph) {
    CArgsP ap0 = (CArgsP)__builtin_amdgcn_kernarg_segment_ptr(); int phv = ph;
    asm volatile("" : "+s"(ap0), "+s"(phv));
#define PHASE_AP CArgsP ap = ap0; asm volatile("" : "+s"(ap));
    int tid = threadIdx.x; asm volatile("" : "+v"(tid));
    const int wid = tid >> 6, lane = tid & 63;
    int G = gridDim.x, cu = blockIdx.x; asm volatile("" : "+s"(G), "+s"(cu));
    const int l = phv / 31, idx = phv % 31;
    if (idx >= 1 && (idx - 1) % 10 == 2) continue;
    if (idx == 0) {
      PHASE_AP
      LAS float* tile = (LAS float*)lds;
      const int dmask = ap->pad;
      if (dmask & 1) { const float* w = ap->in[5] + (size_t)l * DM * NIN;
        tconv(tile, WIN, DM, NWIN, DM, [&](int k, int n) { const int c = win_src(n); return c < 0 ? 0.f : w[(size_t)k * NIN + c]; }, cu, G); }
      if (dmask & 2) { const float* gcq = ap->in[10] + l * 256; const float* gckv = ap->in[11] + l * 128;
        const float* wq = ap->in[12] + (size_t)l * 256 * 384; const float* wk = ap->in[13] + (size_t)l * 128 * 768;
        tconv(tile, WMLA, 384, PMLA, 384, [&](int k, int n) { if (n < 384) return k < 256 ? wq[k * 384 + n] * gcq[k] : 0.f; if (n < 1152) return k >= 256 ? wk[(k - 256) * 768 + (n - 384)] * gckv[k - 256] : 0.f; return 0.f; }, cu, G); }
      if (dmask & 4) { const float* w = ap->in[22] + (size_t)l * DM * 1024;
        tconv(tile, WMEM, DM, 1024, DM, [&](int k, int n) { return w[(size_t)k * 1024 + n]; }, cu, G); }
      if (dmask & 8) { const float* w = ap->in[26] + (size_t)l * 5 * 512 * 1024;
        tconv(tile, WBR, 512, 5120, 512, [&](int k, int n) { return w[((size_t)(n >> 10) * 512 + k) * 1024 + (n & 1023)]; }, cu, G); }
      if (dmask & 16) { const float* w = ap->in[27] + (size_t)l * DM * DM;
        tconv(tile, WOUT, DM, DM, DM, [&](int k, int n) { return w[(size_t)k * DM + n]; }, cu, G); }
      if (l == 0) {
        const float invf[16] = {1.0f, 0.5623413251903491f, 0.31622776601683794f, 0.1778279410038923f, 0.1f, 0.05623413251903491f, 0.03162277660168379f, 0.01778279410038923f,
                                0.01f, 0.005623413251903491f, 0.0031622776601683794f, 0.001778279410038923f, 0.001f, 0.0005623413251903491f, 0.00031622776601683794f, 0.0001778279410038923f};
        for (int e = cu * 512 + tid; e < 8192 * 16; e += G * 512) {
          const int pos = e >> 4, j = e & 15; float iv = invf[0];
#pragma unroll
          for (int q = 1; q < 16; ++q) iv = (j == q) ? invf[q] : iv;
          const float ang = (float)pos * iv;
          const double rev = (double)ang * 0.15915494309189535; const float fr = (float)(rev - __builtin_rint(rev));
          ROPE[pos * 32 + j] = __builtin_amdgcn_cosf(fr); ROPE[pos * 32 + 16 + j] = __builtin_amdgcn_sinf(fr);
        }
      }
    } else {
      const int u = (idx - 1) / 10, p = (idx - 1) % 10;
      const int S = (u == 0) ? 4096 : 8192, nseq = (u == 0) ? 4 : 2, nmem = nseq * 256;
#define XIN ((l == 0) ? ((u == 0) ? ap->in[0] : ap->in[1] + (size_t)(u - 1) * TU * DM) : ap->out + (size_t)u * TU * DM)
#define XOUT (ap->out + (size_t)u * TU * DM)
#define MEMIN ((u == 0) ? ap->in[2] : ap->in[3] + (size_t)(u - 1) * 512 * DM)
      if (p == 0) {
        PHASE_AP
        const float* xin = XIN; const float* memin = MEMIN;
        const float* g1 = ap->in[4] + l * DM; const float* g2 = ap->in[21] + l * DM;
        for (int row = cu * 8 + wid; row < TU + nmem; row += G * 8) {
          const bool ism = row >= TU; const float* src = ism ? memin + (size_t)(row - TU) * DM : xin + (size_t)row * DM;
          const float* gg = ism ? g2 : g1; bf16_t* dst = ism ? MN + (size_t)(row - TU) * DM : H + (size_t)row * DM;
          f32x4 v[4]; float ss = 0.f;
#pragma unroll
          for (int i = 0; i < 4; ++i) { v[i] = *(const f32x4*)(src + i * 256 + lane * 4); ss += v[i][0] * v[i][0] + v[i][1] * v[i][1] + v[i][2] * v[i][2] + v[i][3] * v[i][3]; }
#pragma unroll
          for (int o = 1; o < 64; o <<= 1) ss += __shfl_xor(ss, o);
          const float rr = rsqrtf(ss * (1.0f / DM) + EPS);
#pragma unroll
          for (int i = 0; i < 4; ++i) { const f32x4 gv = *(const f32x4*)(gg + i * 256 + lane * 4);
            u32x2 w; w.x = cvt_pk(v[i][0] * rr * gv[0], v[i][1] * rr * gv[1]); w.y = cvt_pk(v[i][2] * rr * gv[2], v[i][3] * rr * gv[3]);
            *(u32x2*)(dst + i * 256 + lane * 4) = w; }
        }
      } else if (p == 1) {
        PHASE_AP
        { pg8::GridOrder S_; S_.init(H, DM, WIN, DM, TU, NG1, G, cu); pg8::EpiG1a E{QB, KVB, ap->in[6] + l * 64, ap->in[16] + l * 64, ap->in[19] + l * 64, ap->in[7] + l * 64, ap->in[17] + l * 64, ap->in[20] + l * 64}; pg8::gemm_phase(lds, pg8::Gemm{DM, DM, DM}, S_, E); }
        { pg8::GridOrder S_; S_.init(MN, DM, WMEM, DM, nmem, 1024, G, (cu + 64) % G); pg8::EpiPlain E{MKV, PMKV}; pg8::gemm_phase(lds, pg8::Gemm{DM, DM, DM}, S_, E); }
      } else if (p == 2) {
        PHASE_AP
        const float sc64 = 0.125f * LOG2E, sc128 = 0.08838834764831845f * LOG2E;
        const float* a_qn = ap->in[6] + l * 64; const float* a_kn = ap->in[7] + l * 64; const float* b_cqn = ap->in[10] + l * 256; const float* b_ckvn = ap->in[11] + l * 128;
        const float* b_kn = ap->in[15] + l * 96; const float* c_qn = ap->in[16] + l * 64; const float* c_kn = ap->in[17] + l * 64; const float* d_qn = ap->in[19] + l * 64;
        const float* d_kn = ap->in[20] + l * 64; const float* m_qn = ap->in[23] + l * 128; const float* m_kn = ap->in[24] + l * 128;
        const int c8 = (lane & 7) * 8, c16 = (lane & 15) * 8;
        for (int row = cu * 8 + wid; row < TU + nmem; row += G * 8) {
          if (row >= TU) { bf16_t* pk_ = MKV + (size_t)(row - TU) * PMKV + lane * 8; seg_norm<16>(pk_, pk_, true, m_kn + c16, 1.f, nullptr); continue; }
          bf16_t* qb = QB + (size_t)row * PQ + lane * 8; bf16_t* kv = KVB + (size_t)row * PKV + lane * 8;
          const u32x4 r5 = ldraw(qb + QC_MQ, true), r11 = ldraw(kv + KC_CQ, lane < 32), r12 = ldraw(kv + KC_CKV, lane < 16), r13 = ldraw(kv + KC_KR, lane < 4);
          seg_norm<16>(nullptr, qb + QC_MQ, true, m_qn + c16, sc128, nullptr, &r5);
          seg_norm<32>(nullptr, kv + KC_CQ, lane < 32, b_cqn + (lane & 31) * 8, 1.f, nullptr, &r11);
          seg_norm<16>(nullptr, kv + KC_CKV, lane < 16, b_ckvn + c16, 1.f, nullptr, &r12);
          { float v[8]; seg_norm<4>(nullptr, nullptr, lane < 4, b_kn + 64 + (lane & 3) * 8, 1.f, v, &r13);
            const float* rp = ROPE + (size_t)(row % S) * 32; rope4(v, lane & 3, rp, rp + 16);
            if (lane < 4) *(u32x4*)(kv + KC_KR) = pack8(v); }
        }
      } else if (p == 3) {
        PHASE_AP
        pg8::GridOrder S_; S_.init(KVB + KC_CQ, PKV, WMLA, 384, TU, PMLA, G, cu); pg8::EpiPlain E{MLA, PMLA}; pg8::gemm_phase(lds, pg8::Gemm{PKV, 384, 384}, S_, E);
      } else if (p == 4) {
        PHASE_AP
        const float scb = 0.10206207261596575f * LOG2E, sc128 = 0.08838834764831845f * LOG2E;
        const float* b_qn = ap->in[14] + l * 96; const float* b_kn = ap->in[15] + l * 96; const float* m_qn = ap->in[23] + l * 128; const float* m_kn = ap->in[24] + l * 128;
        const int c16 = (lane & 15) * 8;
        for (int row = cu * 8 + wid; row < TU + nmem; row += G * 8) {
          if (row >= TU) { bf16_t* pk_ = MKV + (size_t)(row - TU) * PMKV + lane * 8; seg_norm<16>(pk_, pk_, true, m_kn + c16, 1.f, nullptr); continue; }
          bf16_t* ml = MLA + (size_t)row * PMLA; bf16_t* bk = BK + (size_t)row * PBK; const bf16_t* kvrow = KVB + (size_t)row * PKV; bf16_t* pmq = QB + (size_t)row * PQ + QC_MQ + lane * 8;
          const float* rp = ROPE + (size_t)(row % S) * 32;
          const int hd8 = (lane >> 3) & 3, ch8 = lane & 7, hd4 = (lane >> 2) & 3, ch4 = lane & 3;
          bf16_t* pqn = ml + hd8 * 96 + ch8 * 8; bf16_t* pqr = ml + hd4 * 96 + 64 + ch4 * 8; bf16_t* pv_ = ml + 384 + (lane >> 4) * 192 + 64 + c16;
          const u32x4 rcq = ldraw(kvrow + KC_CQ + lane * 8, lane < 32), rckv = ldraw(kvrow + KC_CKV + lane * 8, lane < 16), rkr = ldraw(kvrow + KC_KR + ch4 * 8, lane < 16), rmq = ldraw(pmq, true),
                      q0r = ldraw(pqn, lane < 32), q1r = ldraw(pqr, lane < 16), q2r = ldraw(ml + 384 + hd8 * 192 + ch8 * 8, lane < 32), rvv = ldraw(pv_, true);
          float sq = 0.f, skv = 0.f;
          { float t8[8]; unpack8(rcq, t8);
#pragma unroll
            for (int i = 0; i < 8; ++i) sq += t8[i] * t8[i];
            unpack8(rckv, t8);
#pragma unroll
            for (int i = 0; i < 8; ++i) skv += t8[i] * t8[i]; }
#pragma unroll
          for (int o = 1; o < 64; o <<= 1) { sq += __shfl_xor(sq, o); skv += __shfl_xor(skv, o); }
          const float r_q = rsqrtf(sq * (1.0f / 256.0f) + EPS), r_kv = rsqrtf(skv * (1.0f / 128.0f) + EPS);
          seg_norm<8>(nullptr, pqn, lane < 32, b_qn + ch8 * 8, scb, nullptr, &q0r, r_q);
          { float v[8]; seg_norm<4>(nullptr, nullptr, lane < 16, b_qn + 64 + ch4 * 8, 1.f, v, &q1r, r_q);
            rope4(v, ch4, rp, rp + 16);
#pragma unroll
            for (int i = 0; i < 8; ++i) v[i] *= scb;
            if (lane < 16) *(u32x4*)pqr = pack8(v); }
          seg_norm<8>(nullptr, bk + hd8 * 96 + ch8 * 8, lane < 32, b_kn + ch8 * 8, 1.f, nullptr, &q2r, r_kv);
          { float v[8]; seg_norm<4>(nullptr, nullptr, lane < 16, b_kn + 64 + ch4 * 8, 1.f, v, &rkr);
            rope4(v, ch4, rp, rp + 16);
            if (lane < 16) *(u32x4*)(bk + hd4 * 96 + 64 + ch4 * 8) = pack8(v); }
          { float v[8]; unpack8(rvv, v);
#pragma unroll
            for (int i = 0; i < 8; ++i) v[i] *= r_kv;
            *(u32x4*)pv_ = pack8(v); }
          seg_norm<16>(nullptr, pmq, true, m_qn + c16, sc128, nullptr, &rmq);
        }
      } else if (p == 5) {
        PHASE_AP
        const int nqb = S / 256, per = nseq * nqb;
        const int nB = per * 4, nA = per * 8, nC = per * 8, nD = per * 24, nM = per * 4, ntot = nB + nA + nC + nD + nM;
        const float* sink = ap->in[18] + l * 8;
        const int BIGW = 1 << 28;
        float gq = fabsf((ap->in[6] + l * 64)[lane]), gk = fabsf((ap->in[7] + l * 64)[lane]);
#pragma unroll
        for (int o = 1; o < 64; o <<= 1) { gq = fmaxf(gq, __shfl_xor(gq, o)); gk = fmaxf(gk, __shfl_xor(gk, o)); }
        const float athr = 2.0f * (8.0f * gq * gk * 1.02f) + 104.0f;
        float gbq = fmaxf(fabsf((ap->in[14] + l * 96)[lane]), fabsf((ap->in[14] + l * 96)[64 + (lane & 31)])), gbk = fmaxf(fabsf((ap->in[15] + l * 96)[lane]), fabsf((ap->in[15] + l * 96)[64 + (lane & 31)]));
        float gcq = fabsf((ap->in[16] + l * 64)[lane]), gck = fabsf((ap->in[17] + l * 64)[lane]), gdq = fabsf((ap->in[19] + l * 64)[lane]), gdk = fabsf((ap->in[20] + l * 64)[lane]);
        float gmq = fmaxf(fabsf((ap->in[23] + l * 128)[lane]), fabsf((ap->in[23] + l * 128)[64 + lane])), gmk = fmaxf(fabsf((ap->in[24] + l * 128)[lane]), fabsf((ap->in[24] + l * 128)[64 + lane]));
#pragma unroll
        for (int o = 1; o < 64; o <<= 1) { gbq = fmaxf(gbq, __shfl_xor(gbq, o)); gbk = fmaxf(gbk, __shfl_xor(gbk, o)); gcq = fmaxf(gcq, __shfl_xor(gcq, o)); gck = fmaxf(gck, __shfl_xor(gck, o));
          gdq = fmaxf(gdq, __shfl_xor(gdq, o)); gdk = fmaxf(gdk, __shfl_xor(gdk, o)); gmq = fmaxf(gmq, __shfl_xor(gmq, o)); gmk = fmaxf(gmk, __shfl_xor(gmk, o)); }
        const float smA = 8.0f * gq * gk * (LOG2E * 1.02f), smB = 9.797959f * gbq * gbk * (LOG2E * 1.02f), smC = 8.0f * gcq * gck * (LOG2E * 1.02f),
                    smD = 8.0f * gdq * gdk * (LOG2E * 1.02f), smM = 11.313708f * gmq * gmk * (LOG2E * 1.02f);
        unsigned* qctr = (unsigned*)(ap->ws + 32768) + (l * 3 + u) * 64;
        volatile LAS unsigned* qslot = (volatile LAS unsigned*)(lds + 131072 + 16);
        for (;;) {
          __syncthreads();
          if (tid == 0) qslot[0] = atomicAdd(qctr, 1u);
          __syncthreads();
          const int it = (int)qslot[0];
          if (it >= ntot) break;
          int j = it;
          if (j < nB) {
            const int blk = j % nqb, hh = (j / nqb) % 4, b = j / (nqb * 4); const size_t r0 = (size_t)b * S;
            attn_item<96, 128, false, false, false>(lds, MLA + r0 * PMLA + hh * 96, PMLA, BK + r0 * PBK + hh * 96, PBK, MLA + r0 * PMLA + 384 + hh * 192 + 64, PMLA,
                               QB + r0 * PQ + QC_OB + hh * 128, PQ, nullptr, 0, blk * 256, S, BIGW, 0.f, 0.f, 0.f);
            continue; }
          j -= nB;
          if (j < nA) {
            const int blk = j % nqb, mm = (j / nqb) & 1, b = (j / (nqb * 2)) % nseq, hh = 3 - j / (nqb * 2 * nseq); const size_t r0 = (size_t)b * S;
            const float sn = exp2f(-2.0f * (hh + 1)), slope = sn * LOG2E; const float wf = athr / sn + 2.0f; const int Wa = wf > 1e8f ? BIGW : (int)wf;
            attn_item<64, 128, true, false, true>(lds, QB + r0 * PQ + QC_AQ + mm * 256 + hh * 64, PQ, KVB + r0 * PKV + KC_AK + mm * 256 + hh * 64, PKV, KVB + r0 * PKV + KC_AV + hh * 128, PKV,
                               QB + r0 * PQ + QC_OA + mm * 512 + hh * 128, PQ, nullptr, 0, blk * 256, S, Wa, slope, 0.f, 0.f);
            continue; }
          j -= nA;
          if (j < nC) {
            const int blk = j % nqb, hq = (j / nqb) % 8, b = j / (nqb * 8), kvh = hq >> 2; const size_t r0 = (size_t)b * S;
            const float slope = exp2f(-(float)(hq + 1)) * LOG2E; const float sk2 = sink[hq] * LOG2E, mC = fmaxf(smC, sk2);
            attn_item<64, 64, true, true, false>(lds, QB + r0 * PQ + QC_CQ + hq * 64, PQ, KVB + r0 * PKV + KC_CK + kvh * 64, PKV, KVB + r0 * PKV + KC_CV + kvh * 64, PKV,
                              QB + r0 * PQ + QC_CQ + hq * 64, PQ, nullptr, 0, blk * 256, S, 128, slope, 0.f, exp2f(sk2));
            continue; }
          j -= nC;
          if (j < nD) {
            const int blk = j % nqb, gh = (j / nqb) % 24, b = j / (nqb * 24), gg = gh >> 3, hh = gh & 7;
            const int dil = gg == 0 ? 1 : gg == 1 ? 4 : 16; const int Ls = S / dil, nbr = Ls / 256, res = blk / nbr, qbk = blk % nbr;
            const size_t r0 = (size_t)b * S + res; const float slope = exp2f(-(float)(hh + 1)) * LOG2E * (float)dil;
            attn_item<64, 64, true, true, false>(lds, QB + r0 * PQ + QC_DQ + gg * 512 + hh * 64, PQ * dil, KVB + r0 * PKV + KC_DK + gg * 512 + hh * 64, PKV * dil, KVB + r0 * PKV + KC_DV + gg * 512 + hh * 64, PKV * dil,
                              QB + r0 * PQ + QC_DQ + gg * 512 + hh * 64, PQ * dil, LSE + r0 * 24 + gg * 8 + hh, 24 * dil, qbk * 256, Ls, 64, slope, 0.f, 0.f);
            continue; }
          j -= nD;
          { const int blk = j % nqb, hh = (j / nqb) % 4, b = j / (nqb * 4); const size_t r0 = (size_t)b * S;
            attn_item<128, 128, false, false, false>(lds, QB + r0 * PQ + QC_MQ + hh * 128, PQ, MKV + (size_t)b * 256 * PMKV + hh * 128, PMKV, MKV + (size_t)b * 256 * PMKV + 512 + hh * 128, PMKV,
                                QB + r0 * PQ + QC_MQ + hh * 128, PQ, nullptr, 0, blk * 256, 256, BIGW, 0.f, 0.f, 0.f); }
        }
      } else if (p == 6) {
        PHASE_AP
        const float* lf = ap->in[8] + l * 256; const float* a_hn = ap->in[9] + l * 128;
        float d01 = lf[lane] * lf[64 + lane], d23 = lf[128 + lane] * lf[192 + lane];
#pragma unroll
        for (int o = 1; o < 64; o <<= 1) { d01 += __shfl_xor(d01, o); d23 += __shfl_xor(d23, o); }
        const float lam_init = 0.8f - 0.6f * expf(-0.3f * (float)l);
        const float lam = expf(d01) - expf(d23) + lam_init;
        const int c16 = (lane & 15) * 8;
        for (int row = cu * 8 + wid; row < TU; row += G * 8) {
          bf16_t* qb = QB + (size_t)row * PQ;
          bf16_t* pA = qb + QC_OA + lane * 8; bf16_t* pD = qb + QC_DQ + lane * 8;
          const u32x4 ra0 = *(const u32x4*)pA, ra1 = *(const u32x4*)(pA + 512), rd0 = *(const u32x4*)pD, rd1 = *(const u32x4*)(pD + 512), rd2 = *(const u32x4*)(pD + 1024);
          const int hd = lane >> 3; const float* ls = LSE + (size_t)row * 24 + hd; const float l0 = ls[0], l1 = ls[8], l2 = ls[16];
          { float a0[8], a1[8]; unpack8(ra0, a0); unpack8(ra1, a1);
            float ss = 0.f;
#pragma unroll
            for (int i = 0; i < 8; ++i) { a0[i] = a0[i] - lam * a1[i]; ss += a0[i] * a0[i]; }
#pragma unroll
            for (int o = 1; o < 16; o <<= 1) ss += __shfl_xor(ss, o);
            const float rr = rsqrtf(ss * (1.0f / 128.0f) + EPS) * (1.0f - lam_init);
#pragma unroll
            for (int i = 0; i < 8; ++i) a0[i] = a0[i] * rr * a_hn[c16 + i];
            *(u32x4*)pA = pack8(a0); }
          { const float mx = fmaxf(l0, fmaxf(l1, l2)); float w0 = fexp2(l0 - mx), w1 = fexp2(l1 - mx), w2 = fexp2(l2 - mx); const float iw = 1.0f / (w0 + w1 + w2);
            w0 *= iw; w1 *= iw; w2 *= iw;
            float a0[8], a1[8], a2[8]; unpack8(rd0, a0); unpack8(rd1, a1); unpack8(rd2, a2);
#pragma unroll
            for (int i = 0; i < 8; ++i) a0[i] = w0 * a0[i] + w1 * a1[i] + w2 * a2[i];
            *(u32x4*)pD = pack8(a0); }
        }
        __syncthreads();
        { pg8::GridOrder S_; S_.init(H, DM, WIN + (size_t)(NG1 + NZ) * DM, DM, TU, NGT, G, cu); pg8::EpiGate E{GATE, ap->in[25] + (size_t)l * 5 * DM}; pg8::gemm_phase(lds, pg8::Gemm{DM, DM, DM}, S_, E); }
      } else if (p == 7) {
        PHASE_AP
        pg8::GridOrder S_; S_.init(H, DM, WIN + (size_t)NG1 * DM, DM, TU, NZ, G, cu); pg8::EpiZ E{QB}; pg8::gemm_phase(lds, pg8::Gemm{DM, DM, DM}, S_, E);
      } else if (p == 8) {
        PHASE_AP
        pg8::MergeOrder S_{(const char*)QB, (const char*)WBR, (TU / 256) * 4, G, cu}; pg8::EpiMerge E{H, GATE, (ap->pad >> 8) & 31}; pg8::gemm_phase(lds, pg8::Gemm{PQ, 512, 512}, S_, E);
      } else {
        PHASE_AP
        const float* xin = XIN; float* xout = XOUT;
        pg8::GridOrder S_; S_.init(H, DM, WOUT, DM, TU, DM, G, cu); pg8::EpiOut E{xin, xout}; pg8::gemm_phase(lds, pg8::Gemm{DM, DM, DM}, S_, E);
      }
    }
    if (ap0->coop && ph + 1 < ph_hi) { if (ap0->coop == 2) grid_sync(); else xcd_barrier(xbar); }
#ifdef DBG
    {
      CArgsP ap = ap0; unsigned* DB = (unsigned*)(ap->ws + WS_DBG);
      int tid = threadIdx.x; const int lane = tid & 63, wid = tid >> 6; const int G = gridDim.x, cu = blockIdx.x;
      if (ph + 1 >= ph_hi) grid_sync();
      if (ph == 0) { if (cu == 0 && tid < 16) DB[tid] = 0u; }
      if (ph == 2) {
        for (int s = cu * 512 + tid; s < 32768; s += G * 512) {
          const unsigned hsh = dbg_hash(s * 2654435761u + 17u); const int t = hsh % TU, n = (hsh >> 14) % (NG1 - 96);
          float ref = 0.f; for (int k = 0; k < DM; ++k) ref += bf2f(H[(size_t)t * DM + k]) * bf2f(WIN[(size_t)n * DM + k]);
          const float got = n < 3072 ? bf2f(QB[(size_t)t * PQ + n]) : bf2f(KVB[(size_t)t * PKV + n - 3072]);
          dbg_max(DB + 0, fabsf(got - ref) / (fabsf(ref) + 0.05f));
        }
        for (int s = cu * 512 + tid; s < 8192; s += G * 512) {
          const unsigned hsh = dbg_hash(s * 2654435761u + 99u); const int t = hsh % 1024, n = (hsh >> 14) % 1024;
          float ref = 0.f; for (int k = 0; k < DM; ++k) ref += bf2f(MN[(size_t)t * DM + k]) * bf2f(WMEM[(size_t)n * DM + k]);
          dbg_max(DB + 3, fabsf(bf2f(MKV[(size_t)t * PMKV + n]) - ref) / (fabsf(ref) + 0.05f));
        }
      }
      if (ph == 4) {
        for (int s = cu * 512 + tid; s < 32768; s += G * 512) {
          const unsigned hsh = dbg_hash(s * 2654435761u + 5u); const int t = hsh % TU, n = (hsh >> 14) % 1152;
          float ref = 0.f; for (int k = 0; k < 384; ++k) ref += bf2f(KVB[(size_t)t * PKV + KC_CQ + k]) * bf2f(WMLA[(size_t)n * 384 + k]);
          dbg_max(DB + 4, fabsf(bf2f(MLA[(size_t)t * PMLA + n]) - ref) / (fabsf(ref) + 0.05f));
        }
      }
      if (ph == 6) {
        const int S = 4096, nqb = 16, per = 64, nB = per * 4, nA = per * 8; LAS float* sc = (LAS float*)lds;
        if (wid == 0) for (int it = cu; it < nB + nA; it += G) {
          const int rq = (it * 97 + 13) & 255; float e;
          if (it < nB) { const int j = it, blk = j % nqb, hh = (j / nqb) % 4, b = j / (nqb * 4); const size_t r0 = (size_t)b * S;
            e = dbg_attn_row<96, 128>(sc, MLA + r0 * PMLA + hh * 96, PMLA, BK + r0 * PBK + hh * 96, PBK, MLA + r0 * PMLA + 384 + hh * 192 + 64, PMLA, QB + r0 * PQ + QC_OB + hh * 128, PQ,
                                      blk * 256 + rq, S, 1 << 28, 0.f, -1e30f, 0.f, lane);
            if (lane == 0) dbg_max(DB + 2, e);
          } else { const int j = it - nB, blk = j % nqb, mh = (j / nqb) % 8, b = j / (nqb * 8), mm = mh >> 2, hh = mh & 3; const size_t r0 = (size_t)b * S;
            const float slope = exp2f(-2.0f * (hh + 1)) * LOG2E;
            e = dbg_attn_row<64, 128>(sc, QB + r0 * PQ + QC_AQ + mm * 256 + hh * 64, PQ, KVB + r0 * PKV + KC_AK + mm * 256 + hh * 64, PKV, KVB + r0 * PKV + KC_AV + hh * 128, PKV,
                                      QB + r0 * PQ + QC_OA + mm * 512 + hh * 128, PQ, blk * 256 + rq, S, 1 << 28, slope, -1e30f, 0.f, lane);
            if (lane == 0) dbg_max(DB + 1, e);
          }
        }
      }
      if (ph == 7) {
        const float* bg = ap->in[25];
        for (int s = cu * 512 + tid; s < 32768; s += G * 512) {
          const unsigned hsh = dbg_hash(s * 2654435761u + 7u); const int t = hsh % TU, n = (hsh >> 14) % NGT;
          float ref = 0.f; for (int k = 0; k < DM; ++k) ref += bf2f(H[(size_t)t * DM + k]) * bf2f(WIN[(size_t)(NG1 + NZ + n) * DM + k]);
          ref = 1.f / (1.f + expf(-(ref + bg[n])));
          dbg_max(DB + 8, fabsf(bf2f(GATE[(size_t)t * PGATE + n]) - ref) / (fabsf(ref) + 0.05f));
        }
      }
      if (ph == 9) {
        for (int s = cu * 512 + tid; s < 32768; s += G * 512) {
          const unsigned hsh = dbg_hash(s * 2654435761u + 9u); const int t = hsh % TU, c = (hsh >> 14) % DM;
          float ref = 0.f;
          for (int br = 0; br < 5; ++br) { const int ocol = br == 0 ? QC_OA : br == 1 ? QC_OB : br == 2 ? QC_CQ : br == 3 ? QC_DQ : QC_MQ;
            float tt = 0.f; for (int k = 0; k < 512; ++k) tt += bf2f(QB[(size_t)t * PQ + ocol + k]) * bf2f(WBR[(size_t)(br * 1024 + c) * 512 + k]);
            ref += bf2f(GATE[(size_t)t * PGATE + br * 1024 + c]) * tt; }
          dbg_max(DB + 9, fabsf(bf2f(H[(size_t)t * DM + c]) - ref) / (fabsf(ref) + 0.05f));
        }
      }
      if (ph == 10) {
        for (int s = cu * 512 + tid; s < 32768; s += G * 512) {
          const unsigned hsh = dbg_hash(s * 2654435761u + 11u); const int t = hsh % TU, c = (hsh >> 14) % DM;
          float ref = 0.f; for (int k = 0; k < DM; ++k) ref += bf2f(H[(size_t)t * DM + k]) * bf2f(WOUT[(size_t)c * DM + k]);
          ref += ap->in[0][(size_t)t * DM + c];
          dbg_max(DB + 10, fabsf(ap->out[(size_t)t * DM + c] - ref) / (fabsf(ref) + 0.05f));
        }
      }
      if (ph == 2 || ph == 4 || ph == 6 || ph == 0 || ph == 7 || ph == 9) grid_sync();
      if (ph + 1 == ph_hi) {
        grid_sync();
        const float e1 = __uint_as_float(DB[DBG_SEL1]), e2 = __uint_as_float(DB[DBG_SEL2]);
        const float k1 = fminf(fmaxf(log10f(e1 + 1e-30f) + 5.f, 0.f), 7.f), k2 = fminf(fmaxf(log10f(e2 + 1e-30f) + 5.f, 0.f), 7.f);
        for (size_t i = (size_t)cu * 512 + tid; i < (size_t)49152 * DM; i += (size_t)G * 512) {
          const float xv = i < (size_t)TU * DM ? ap->in[0][i] : ap->in[1][i - (size_t)TU * DM];
          ap->out[i] = (i == 0) ? 100.f * k2 : xv * (1.f + k1);
        }
      }
    }
#endif
  }
}

extern "C" void kernel_launch(void* const* d_in, const int* in_sizes, int n_in, void* d_out, int out_size, void* d_ws, size_t ws_size, hipStream_t stream) {
  static int grid = 0;
  if (!grid) {
    if (n_in != 28 || ws_size < WS_END) { fprintf(stderr, "kernel_launch: unexpected n_in %d or ws_size %zu (< %zu)\n", n_in, ws_size, (size_t)WS_END); grid = -1; }
    else {
      int dev = 0, cus = 0, per_cu = 0;
      hipGetDevice(&dev); hipDeviceGetAttribute(&cus, hipDeviceAttributeMultiprocessorCount, dev);
      hipFuncSetAttribute((const void*)mega, hipFuncAttributeMaxDynamicSharedMemorySize, LDS_BYTES);
      hipOccupancyMaxActiveBlocksPerMultiprocessor(&per_cu, mega, 512, LDS_BYTES);
      grid = cus * (per_cu > 0 ? 1 : 0);
      if (grid > 256) grid = 256;
      if (grid <= 0) { fprintf(stderr, "kernel_launch: occupancy query says %d blocks/CU\n", per_cu); grid = -1; }
    }
  }
  if (grid <= 0) return;
  Args a{};
  for (int i = 0; i < 28; ++i) a.in[i] = (const float*)d_in[i];
  a.out = (float*)d_out; a.ws = (unsigned char*)d_ws; a.ph_lo = 0; a.ph_hi = DBG_PH_HI; a.coop = 1; a.pad = 31 | (DBG_BMASK << 8);
  if (hipMemsetAsync(d_ws, 0, 65536, stream) != hipSuccess) { fprintf(stderr, "kernel_launch: memset of barrier words failed\n"); return; }
  void* params[] = {&a};
  hipError_t e = hipLaunchCooperativeKernel((const void*)mega, dim3(grid), dim3(512), params, LDS_BYTES, stream);
  if (e != hipSuccess) fprintf(stderr, "cooperative launch failed: %s (grid %d)\n", hipGetErrorString(e), grid);
}
```

```cpp
#include <hip/hip_runtime.h>
#include <hip/hip_cooperative_groups.h>
#include <cstdio>
#include <cstdint>
namespace cg = cooperative_groups;

#define LAS __attribute__((address_space(3)))
#define DI __device__ __forceinline__
typedef unsigned short bf16_t;
typedef short bf16x8 __attribute__((ext_vector_type(8)));
typedef short s16x4 __attribute__((ext_vector_type(4)));
typedef float f32x4 __attribute__((ext_vector_type(4)));
typedef float f32x16 __attribute__((ext_vector_type(16)));
typedef unsigned u32x4 __attribute__((ext_vector_type(4)));
typedef unsigned u32x2 __attribute__((ext_vector_type(2)));

constexpr int DM = 1024, NIN = 15520, TU = 16384  , NUNIT = 3, DEPTH = 2;
constexpr int PQ = 4608, PKV = 4864, PMLA = 1280, PBK = 384, PGATE = 5120, PMKV = 1024;
constexpr int NG1 = 7936, NZ = 2560, NGT = 5120, NWIN = NG1 + NZ + NGT;
constexpr float LOG2E = 1.4426950408889634f, EPS = 1e-6f;
constexpr int QC_AQ = 0, QC_CQ = 512, QC_DQ = 1024, QC_MQ = 2560, QC_OA = 3072, QC_OB = 4096;
constexpr int KC_AK = 0, KC_AV = 512, KC_CK = 1024, KC_CV = 1152, KC_DK = 1280, KC_DV = 2816, KC_CQ = 4352, KC_CKV = 4608, KC_KR = 4736;
constexpr size_t MiB = 1u << 20;
constexpr size_t WS_ROPE = 1 * MiB, WS_WIN = 2 * MiB, WS_WMLA = 33 * MiB, WS_WMEM = 34 * MiB, WS_WBR = 38 * MiB, WS_WOUT = 43 * MiB,
                 WS_MN = 45 * MiB, WS_MKV = 47 * MiB, WS_LSE = 51 * MiB, WS_H = 54 * MiB, WS_QB = 86 * MiB, WS_KVB = 230 * MiB,
                 WS_MLA = 382 * MiB, WS_BK = 422 * MiB, WS_GATE = 230 * MiB, WS_END = 434 * MiB;
constexpr int LDS_BYTES = 131072 + 256;

#define DBG_SEL1 9
#define DBG_SEL2 10
#ifdef DBG
#define DBG_PH_HI 11
#else
#define DBG_PH_HI 62
#endif
#ifndef DBG_BMASK
#define DBG_BMASK 31
#endif
struct Args { const float* in[28]; float* out; unsigned char* ws; int ph_lo, ph_hi, coop, pad; };

DI float bf2f(unsigned short b) { return __uint_as_float(((unsigned)b) << 16); }
typedef __bf16 bf16x2_t __attribute__((ext_vector_type(2)));
typedef float f32x2_t __attribute__((ext_vector_type(2)));
DI unsigned cvt_pk(float lo, float hi) { const f32x2_t v = {lo, hi}; const bf16x2_t b = __builtin_convertvector(v, bf16x2_t); return __builtin_bit_cast(unsigned, b); }
DI void unpack8(const u32x4 w, float* v) {
#pragma unroll
  for (int i = 0; i < 4; ++i) { v[2 * i] = __uint_as_float(w[i] << 16); v[2 * i + 1] = __uint_as_float(w[i] & 0xffff0000u); }
}
DI u32x4 pack8(const float* v) { u32x4 w; w.x = cvt_pk(v[0], v[1]); w.y = cvt_pk(v[2], v[3]); w.z = cvt_pk(v[4], v[5]); w.w = cvt_pk(v[6], v[7]); return w; }
DI float fexp2(float x) { return __builtin_amdgcn_exp2f(x); }
DI float sigmoidf_(float x) { return __builtin_amdgcn_rcpf(1.0f + fexp2(-x * LOG2E)); }

namespace pg8 {
constexpr int BM = 256, BK = 64, HALF = 128, HTB = HALF * BK * 2, NXCD = 8, WGM = 8;
__host__ __device__ __forceinline__ int lds_byte(int r, int c) { const int st = (r >> 4) * 2 + (c >> 5), rr = r & 15, cc = c & 31, ob = rr * 64 + cc * 2; return st * 1024 + (ob ^ (((ob >> 9) & 1) << 5)); }
__host__ __device__ __forceinline__ void stage_rc(int b, int& R, int& C) { const int st = b / 1024, sb = b % 1024, swz = sb ^ (((sb >> 9) & 1) << 5); R = (st >> 1) * 16 + swz / 64; C = (st & 1) * 32 + (swz % 64) / 2; }
__host__ __device__ __forceinline__ int perm32(int rho) { const int n = rho >> 4, i = rho & 15; return 8 * (i >> 2) + 4 * n + (i & 3); }

struct Unit { const char* a; const char* b; int pm, pn, aux; };
struct Gemm { int lda, ldb, K; };

struct GridOrder {
  const char* A; const char* B; int lda, ldb, nM, nN, nwg, G, c;
  DI void init(const void* A_, int lda_, const void* B_, int ldb_, int M, int N, int G_, int c_) { A = (const char*)A_; B = (const char*)B_; lda = lda_; ldb = ldb_; nM = M / BM; nN = N / BM; nwg = nM * nN; G = G_; c = c_; }
  DI bool next(int i, Unit& u) const {
    const long L = (long)i * G + c; if (L >= nwg) return false;
    int wgid = (int)L; { const int q = nwg / NXCD, r = nwg % NXCD, xcd = wgid % NXCD, off = wgid / NXCD; wgid = (xcd < r ? xcd * (q + 1) : r * (q + 1) + (xcd - r) * q) + off; }
    const int nig = WGM * nN, gid = wgid / nig, fm = gid * WGM, gsz = (nM - fm) < WGM ? (nM - fm) : WGM;
    u.pm = fm + ((wgid % nig) % gsz); u.pn = (wgid % nig) / gsz; u.aux = 0;
    u.a = A + (size_t)u.pm * BM * lda * 2; u.b = B + (size_t)u.pn * BM * ldb * 2; return true;
  }
};
struct MergeOrder {
  const char* QBp; const char* WBR; int ntiles, G, c;
  DI bool next(int i, Unit& u) const {
    const int k = i / 5, br = i - k * 5; const int tile = c + k * G; if (tile >= ntiles) return false;
    u.pm = tile >> 2; u.pn = tile & 3; u.aux = br;
    const int ocol = br == 0 ? QC_OA : br == 1 ? QC_OB : br == 2 ? QC_CQ : br == 3 ? QC_DQ : QC_MQ;
    u.a = QBp + ((size_t)u.pm * BM * PQ + ocol) * 2; u.b = WBR + ((size_t)(br * 1024 + u.pn * BM) * 512) * 2; return true;
  }
};

template <class Epi, class Sched>
DI void gemm_phase(LAS unsigned char* lds, const Gemm g, const Sched& S, const Epi& E) {
  int tid = threadIdx.x; asm volatile("" : "+v"(tid));
  const int wid = __builtin_amdgcn_readfirstlane(tid >> 6), lane = tid & 63, wr = wid >> 2, wc = wid & 3, fr = lane & 15, fq = lane >> 4;
  const int K = g.K, nt = K / BK;
  unsigned voffA[2], voffB[2];
#pragma unroll
  for (int i = 0; i < 2; ++i) { int R, C; stage_rc(tid * 16 + i * 8192, R, C); const int Rb = (R & ~31) + perm32(R & 31);
    voffA[i] = (unsigned)(R * g.lda + C) * 2u; voffB[i] = (unsigned)(Rb * g.ldb + C) * 2u; }
  const size_t kstep = (size_t)(BK * 2);
  const size_t hstepA = (size_t)HALF * g.lda * 2, hstepB = (size_t)HALF * g.ldb * 2;
  const unsigned ldsw = (unsigned)wid * 1024u;
  const int aoff = lds_byte(wr * 64 + fr, fq * 8), boff = lds_byte(wc * 32 + fr, fq * 8);
#define PG8_SA(b, h) (((b) * 2 + (h)) * HTB)
#define PG8_SB(b, h) ((4 + (b) * 2 + (h)) * HTB)
#define PG8_STAGE(bufoff, gbase, voff) do { _Pragma("unroll") for (int _i = 0; _i < 2; ++_i) \
    __builtin_amdgcn_global_load_lds((const unsigned*)((const char*)(gbase) + (voff)[_i]), (LAS unsigned*)(lds + (bufoff) + ldsw + _i * 8192), 16, 0, 0); } while (0)
#define PG8_LDA(dst, b, h) do { _Pragma("unroll") for (int m = 0; m < 4; ++m) _Pragma("unroll") for (int k = 0; k < 2; ++k) dst[m][k] = *(const LAS bf16x8*)(lds + PG8_SA(b, h) + aoff + m * 2048 + k * 1024); } while (0)
#define PG8_LDB(dst, b, h) do { _Pragma("unroll") for (int n = 0; n < 2; ++n) _Pragma("unroll") for (int k = 0; k < 2; ++k) dst[n][k] = *(const LAS bf16x8*)(lds + PG8_SB(b, h) + boff + n * 2048 + k * 1024); } while (0)
#define PG8_MMA(ai, bj, At, Bt) do { __builtin_amdgcn_s_setprio(1); _Pragma("unroll") for (int m = 0; m < 4; ++m) _Pragma("unroll") for (int n = 0; n < 2; ++n) _Pragma("unroll") for (int k = 0; k < 2; ++k) \
    acc[ai][bj][m][n] = __builtin_amdgcn_mfma_f32_16x16x32_bf16(Bt[n][k], At[m][k], acc[ai][bj][m][n], 0, 0, 0); __builtin_amdgcn_s_setprio(0); } while (0)
#define PG8_WAIT_V(n) asm volatile("s_waitcnt vmcnt(" #n ")" ::: "memory")
#define PG8_WAIT_L(n) asm volatile("s_waitcnt lgkmcnt(" #n ")" ::: "memory")
#define PG8_BAR __builtin_amdgcn_s_barrier()
#define PG8_SCHED __builtin_amdgcn_sched_barrier(0)
  Unit cur, nxt; int ui = 0;
  if (!S.next(0, cur)) return;
  f32x4 acc[2][2][4][2];
#pragma unroll
  for (int a = 0; a < 2; ++a)
#pragma unroll
    for (int b = 0; b < 2; ++b)
#pragma unroll
      for (int m = 0; m < 4; ++m)
#pragma unroll
        for (int n = 0; n < 2; ++n) acc[a][b][m][n] = (f32x4){0.f, 0.f, 0.f, 0.f};
  bf16x8 At[4][2], B0[2][2], B1[2][2];
  const char* cA = cur.a; const char* cB = cur.b;
  PG8_STAGE(PG8_SB(0, 0), cB, voffB); PG8_STAGE(PG8_SB(0, 1), cB + hstepB, voffB); PG8_STAGE(PG8_SA(0, 0), cA, voffA); PG8_STAGE(PG8_SA(0, 1), cA + hstepA, voffA);
  if (wr == 1) PG8_BAR;
  PG8_WAIT_V(2); PG8_BAR;
  PG8_STAGE(PG8_SB(1, 0), cB + kstep, voffB); PG8_STAGE(PG8_SA(1, 0), cA + kstep, voffA); PG8_STAGE(PG8_SB(1, 1), cB + hstepB + kstep, voffB);
  PG8_WAIT_V(6); PG8_BAR;
  for (;;) {
    const bool has_next = S.next(ui + 1, nxt);
    const char* nA = has_next ? nxt.a : cA; const char* nB = has_next ? nxt.b : cB;
    for (int t = 0; t < nt; t += 2) {
      const bool last = (t == nt - 2);
      const char* a1 = cA + (size_t)(t + 1) * kstep;
      const char* a2 = last ? nA : cA + (size_t)(t + 2) * kstep; const char* b2 = last ? nB : cB + (size_t)(t + 2) * kstep;
      const char* a3 = a2 + kstep; const char* b3 = b2 + kstep;
      PG8_LDB(B0, 0, 0); PG8_LDB(B1, 0, 1); PG8_SCHED; PG8_LDA(At, 0, 0); PG8_STAGE(PG8_SA(1, 1), a1 + hstepA, voffA);
      PG8_WAIT_V(8); PG8_WAIT_L(0); PG8_BAR; PG8_MMA(0, 0, At, B0); PG8_MMA(0, 1, At, B1); PG8_BAR; PG8_SCHED;
      PG8_LDA(At, 0, 1); PG8_STAGE(PG8_SB(0, 0), b2, voffB); PG8_STAGE(PG8_SB(0, 1), b2 + hstepB, voffB); PG8_STAGE(PG8_SA(0, 0), a2, voffA);
      PG8_WAIT_V(8); PG8_WAIT_L(0); PG8_BAR; PG8_MMA(1, 0, At, B0); PG8_MMA(1, 1, At, B1); PG8_BAR; PG8_SCHED;
      PG8_LDB(B0, 1, 0); PG8_LDB(B1, 1, 1); PG8_SCHED; PG8_LDA(At, 1, 0); PG8_STAGE(PG8_SA(0, 1), a2 + hstepA, voffA);
      PG8_WAIT_V(8); PG8_WAIT_L(0); PG8_BAR; PG8_MMA(0, 0, At, B0); PG8_MMA(0, 1, At, B1); PG8_BAR; PG8_SCHED;
      PG8_LDA(At, 1, 1); PG8_STAGE(PG8_SB(1, 0), b3, voffB); PG8_STAGE(PG8_SB(1, 1), b3 + hstepB, voffB); PG8_STAGE(PG8_SA(1, 0), a3, voffA);
      PG8_WAIT_V(8); PG8_WAIT_L(0); PG8_BAR; PG8_MMA(1, 0, At, B0); PG8_MMA(1, 1, At, B1); PG8_BAR; PG8_SCHED;
    }
    if (wr == 0) PG8_BAR;
    E(acc, cur, wr, wc, fr, fq);
    if (!has_next) break;
    bool carry = false;
    if constexpr (Epi::KEEPS) carry = E.keep(cur);
    if (!carry) {
#pragma unroll
    for (int a = 0; a < 2; ++a)
#pragma unroll
      for (int b = 0; b < 2; ++b)
#pragma unroll
        for (int m = 0; m < 4; ++m)
#pragma unroll
          for (int n = 0; n < 2; ++n) acc[a][b][m][n] = (f32x4){0.f, 0.f, 0.f, 0.f};
    }
    cur = nxt; cA = nA; cB = nB; ++ui;
    if (wr == 1) PG8_BAR;
  }
  PG8_WAIT_V(0);
  PG8_BAR;
#undef PG8_SA
#undef PG8_SB
#undef PG8_STAGE
#undef PG8_LDA
#undef PG8_LDB
#undef PG8_MMA
#undef PG8_WAIT_V
#undef PG8_WAIT_L
#undef PG8_BAR
#undef PG8_SCHED
}

template <class F> DI void epi_each(const f32x4 (&acc)[2][2][4][2], int wr, int wc, int fr, int fq, F f) {
  asm volatile("" : "+v"(fr), "+v"(fq));
#pragma unroll
  for (int ai = 0; ai < 2; ++ai)
#pragma unroll
    for (int m = 0; m < 4; ++m) { const int row = ai * HALF + wr * 64 + m * 16 + fr;
#pragma unroll
      for (int bj = 0; bj < 2; ++bj) { const int col = bj * HALF + wc * 32 + 8 * fq; f(row, col, acc[ai][bj][m][0], acc[ai][bj][m][1]); } }
}
DI u32x4 pk8(const f32x4 a, const f32x4 b) { u32x4 w; w.x = cvt_pk(a[0], a[1]); w.y = cvt_pk(a[2], a[3]); w.z = cvt_pk(b[0], b[1]); w.w = cvt_pk(b[2], b[3]); return w; }

__host__ __device__ __forceinline__ bool g1a_perm_tile(int pn) { return pn < 10 || pn == 12 || pn == 13 || (pn >= 16 && pn <= 22); }
struct EpiG1a {
  static constexpr bool KEEPS = false;
  bf16_t* QBp; bf16_t* KVBp; const float* a_qn; const float* c_qn; const float* d_qn; const float* a_kn; const float* c_kn; const float* d_kn;
  DI void operator()(const f32x4 (&acc)[2][2][4][2], const Unit& u, int wr, int wc, int fr, int fq) const {
    bf16_t* base; int ld; const int pn = u.pn;
    if (pn < 12) { base = QBp + pn * BM; ld = PQ; } else { base = KVBp + (pn - 12) * BM; ld = PKV; }
    base += (size_t)u.pm * BM * ld;
    if (!g1a_perm_tile(pn)) {
      epi_each(acc, wr, wc, fr, fq, [&](int row, int col, const f32x4 v0, const f32x4 v1) { *(u32x4*)(base + (size_t)row * ld + col) = pk8(v0, v1); });
      return;
    }
    asm volatile("" : "+v"(fr), "+v"(fq));
    const float* gp; float post = 1.0f; bool norm = true;
    if (pn < 2) { gp = a_qn; post = 0.125f * LOG2E; } else if (pn < 4) { gp = c_qn; post = 0.125f * LOG2E; } else if (pn < 10) { gp = d_qn; post = 0.125f * LOG2E; }
    else if (pn < 14) gp = a_kn; else if (pn == 16) { gp = c_kn; norm = wc < 2; } else gp = d_kn;
    const f32x4 g00 = *(const f32x4*)(gp + 8 * fq), g01 = *(const f32x4*)(gp + 8 * fq + 4), g10 = *(const f32x4*)(gp + 32 + 8 * fq), g11 = *(const f32x4*)(gp + 32 + 8 * fq + 4);
#pragma unroll
    for (int ai = 0; ai < 2; ++ai)
#pragma unroll
      for (int m = 0; m < 4; ++m) {
        const int row = ai * HALF + wr * 64 + m * 16 + fr;
        f32x4 v00 = acc[ai][0][m][0], v01 = acc[ai][0][m][1], v10 = acc[ai][1][m][0], v11 = acc[ai][1][m][1];
        float ss = 0.f;
#pragma unroll
        for (int j = 0; j < 4; ++j) ss += v00[j] * v00[j] + v01[j] * v01[j] + v10[j] * v10[j] + v11[j] * v11[j];
        ss += __shfl_xor(ss, 16); ss += __shfl_xor(ss, 32);
        if (norm) { const float r = rsqrtf(ss * (1.0f / 64.0f) + EPS) * post; v00 = v00 * r * g00; v01 = v01 * r * g01; v10 = v10 * r * g10; v11 = v11 * r * g11; }
        bf16_t* p = base + (size_t)row * ld + wc * 64 + 8 * fq;
        *(u32x4*)p = pk8(v00, v01); *(u32x4*)(p + 32) = pk8(v10, v11);
      }
  }
};
struct EpiPlain {
  static constexpr bool KEEPS = false;
  bf16_t* C; int ldc;
  DI void operator()(const f32x4 (&acc)[2][2][4][2], const Unit& u, int wr, int wc, int fr, int fq) const {
    bf16_t* base = C + (size_t)u.pm * BM * ldc + u.pn * BM;
    epi_each(acc, wr, wc, fr, fq, [&](int row, int col, const f32x4 v0, const f32x4 v1) { *(u32x4*)(base + (size_t)row * ldc + col) = pk8(v0, v1); });
  }
};
struct EpiGate {
  static constexpr bool KEEPS = false;
  bf16_t* C; const float* bias;
  DI void operator()(const f32x4 (&acc)[2][2][4][2], const Unit& u, int wr, int wc, int fr, int fq) const {
    bf16_t* base = C + (size_t)u.pm * BM * PGATE + u.pn * BM; const float* bb = bias + u.pn * BM;
    epi_each(acc, wr, wc, fr, fq, [&](int row, int col, f32x4 v0, f32x4 v1) {
      const f32x4 b0 = *(const f32x4*)(bb + col), b1 = *(const f32x4*)(bb + col + 4);
#pragma unroll
      for (int j = 0; j < 4; ++j) { v0[j] = sigmoidf_(v0[j] + b0[j]); v1[j] = sigmoidf_(v1[j] + b1[j]); }
      *(u32x4*)(base + (size_t)row * PGATE + col) = pk8(v0, v1); });
  }
};
struct EpiZ {
  static constexpr bool KEEPS = false;
  bf16_t* QBp; const float* LSEp;
  DI void operator()(const f32x4 (&acc)[2][2][4][2], const Unit& u, int wr, int wc, int fr, int fq) const {
    const int br = u.pn >> 1; const int ocol = (br == 0 ? QC_OA : br == 1 ? QC_OB : br == 2 ? QC_CQ : br == 3 ? QC_DQ : QC_MQ) + (u.pn & 1) * BM;
    bf16_t* base = QBp + (size_t)u.pm * BM * PQ + ocol;
    if (br == 3) {
      const float* lsb = LSEp + (size_t)u.pm * BM * 24 + (u.pn & 1) * 4;
      epi_each(acc, wr, wc, fr, fq, [&](int row, int col, f32x4 v0, f32x4 v1) {
        bf16_t* p = base + (size_t)row * PQ + col; float o[8], o1[8], o2[8]; unpack8(*(const u32x4*)p, o); unpack8(*(const u32x4*)(p + 512), o1); unpack8(*(const u32x4*)(p + 1024), o2);
        const float* ls = lsb + (size_t)row * 24 + (col >> 6); const float l0 = ls[0], l1 = ls[8], l2 = ls[16];
        const float mx = fmaxf(l0, fmaxf(l1, l2)); float w0 = fexp2(l0 - mx), w1 = fexp2(l1 - mx), w2 = fexp2(l2 - mx); const float iw = __builtin_amdgcn_rcpf(w0 + w1 + w2);
        w0 *= iw; w1 *= iw; w2 *= iw;
#pragma unroll
        for (int j = 0; j < 8; ++j) o[j] = w0 * o[j] + w1 * o1[j] + w2 * o2[j];
#pragma unroll
        for (int j = 0; j < 4; ++j) { v0[j] = o[j] * v0[j] * sigmoidf_(v0[j]); v1[j] = o[4 + j] * v1[j] * sigmoidf_(v1[j]); }
        *(u32x4*)p = pk8(v0, v1); });
      return;
    }
    epi_each(acc, wr, wc, fr, fq, [&](int row, int col, f32x4 v0, f32x4 v1) {
      bf16_t* p = base + (size_t)row * PQ + col; float o[8]; unpack8(*(const u32x4*)p, o);
#pragma unroll
      for (int j = 0; j < 4; ++j) { v0[j] = o[j] * v0[j] * sigmoidf_(v0[j]); v1[j] = o[4 + j] * v1[j] * sigmoidf_(v1[j]); }
      *(u32x4*)p = pk8(v0, v1); });
  }
};
struct EpiMerge {
  static constexpr bool KEEPS = true;
  bf16_t* ACC; const bf16_t* GATEp; int bmask;
  DI bool keep(const Unit& u) const { return u.aux < 4; }
  DI void operator()(f32x4 (&acc)[2][2][4][2], const Unit& u, int wr, int wc, int fr, int fq) const {
    asm volatile("" : "+v"(fr), "+v"(fq));
    const int br = u.aux;
    bf16_t* base = ACC + (size_t)u.pm * BM * DM + u.pn * BM; const bf16_t* gb = GATEp + (size_t)u.pm * BM * PGATE + br * 1024 + u.pn * BM;
#pragma unroll
    for (int ai = 0; ai < 2; ++ai)
#pragma unroll
      for (int m = 0; m < 4; ++m) { const int row = ai * HALF + wr * 64 + m * 16 + fr;
#pragma unroll
        for (int bj = 0; bj < 2; ++bj) { const int col = bj * HALF + wc * 32 + 8 * fq;
          float g0[8]; unpack8(*(const u32x4*)(gb + (size_t)row * PGATE + col), g0);
          if (br < 4) { float g1[8]; unpack8(*(const u32x4*)(gb + 1024 + (size_t)row * PGATE + col), g1);
#pragma unroll
            for (int j = 0; j < 4; ++j) { acc[ai][bj][m][0][j] *= g0[j] * __builtin_amdgcn_rcpf(fmaxf(g1[j], 1e-20f)); acc[ai][bj][m][1][j] *= g0[4 + j] * __builtin_amdgcn_rcpf(fmaxf(g1[4 + j], 1e-20f)); }
          } else { f32x4 v0 = acc[ai][bj][m][0], v1 = acc[ai][bj][m][1];
#pragma unroll
            for (int j = 0; j < 4; ++j) { v0[j] *= g0[j]; v1[j] *= g0[4 + j]; }
            *(u32x4*)(base + (size_t)row * DM + col) = pk8(v0, v1); } } }
  }
};
struct EpiOut {
  static constexpr bool KEEPS = false;
  const float* X; float* Y;
  DI void operator()(const f32x4 (&acc)[2][2][4][2], const Unit& u, int wr, int wc, int fr, int fq) const {
    const size_t off = (size_t)u.pm * BM * DM + u.pn * BM;
    epi_each(acc, wr, wc, fr, fq, [&](int row, int col, const f32x4 v0, const f32x4 v1) {
      const size_t o = off + (size_t)row * DM + col; const f32x4 x0 = *(const f32x4*)(X + o), x1 = *(const f32x4*)(X + o + 4);
      *(f32x4*)(Y + o) = x0 + v0; *(f32x4*)(Y + o + 4) = x1 + v1; });
  }
};
}

DI void grid_sync() {
  __builtin_amdgcn_fence(__ATOMIC_RELEASE, "agent");
  asm volatile("s_waitcnt vmcnt(0)" ::: "memory");
  cg::this_grid().sync();
  __builtin_amdgcn_fence(__ATOMIC_ACQUIRE, "agent");
  asm volatile("s_waitcnt vmcnt(0)" ::: "memory");
}

#define XB_TMO      128
#define XB_XCNT(j)  (256  + 64 * (j))
#define XB_XSUB(j)  (1280 + 64 * (j))
#define XB_XGEN(j)  (2304 + 64 * (j))
#define XB_TOP      3328
#define XB_TOPGEN   3392
#define XCD_BAR_WORDS 3456
#define XB_SPIN_CAP (1u << 22)
DI unsigned xb_ld(unsigned* p)              { return __hip_atomic_load(p, __ATOMIC_RELAXED, __HIP_MEMORY_SCOPE_AGENT); }
DI unsigned xb_add(unsigned* p, unsigned v) { return __hip_atomic_fetch_add(p, v, __ATOMIC_RELAXED, __HIP_MEMORY_SCOPE_AGENT); }
DI unsigned xb_xcc_id() { return (unsigned)__builtin_amdgcn_s_getreg((3 << 11) | 20) & 0xFu; }
#define XB_SPIN(cond, bar) do { unsigned _sp = 0; while (cond) { __builtin_amdgcn_s_sleep(1); \
    if ((++_sp & 255u) == 0u) { if (xb_ld(&(bar)[XB_TMO])) break; if (_sp > XB_SPIN_CAP) { atomicAdd(&(bar)[XB_TMO], 1u); break; } } } } while (0)
struct XcdBarrier { unsigned* bar; unsigned x; volatile LAS unsigned* st; };
DI XcdBarrier xcd_barrier_post(unsigned* bar, volatile LAS unsigned* st) {
  XcdBarrier b; b.bar = bar; b.x = xb_xcc_id(); b.st = st;
  if (threadIdx.x == 0) (void)xb_add(&bar[XB_XCNT(b.x)], 1u);
  return b;
}
DI void xcd_barrier_complete(unsigned* bar, unsigned x, unsigned& nloc, unsigned& nx) {
  const unsigned G = gridDim.x * gridDim.y * gridDim.z;
  unsigned sum, cnt, mine, sp = 0u;
  for (;;) {
    sum = 0u; cnt = 0u; mine = 0u;
#pragma unroll
    for (unsigned j = 0; j < 16; ++j) { const unsigned c = xb_ld(&bar[XB_XCNT(j)]); sum += c; cnt += (c > 0u) ? 1u : 0u; mine = (j == x) ? c : mine; }
    if (sum == G) break;
    __builtin_amdgcn_s_sleep(1);
    if ((++sp & 255u) == 0u) { if (xb_ld(&bar[XB_TMO])) break; if (sp > XB_SPIN_CAP) { atomicAdd(&bar[XB_TMO], 1u); break; } }
  }
  nloc = mine > 0u ? mine : 1u; nx = cnt > 0u ? cnt : 1u;
}
DI void xcd_barrier(const XcdBarrier& b) {
  asm volatile("s_waitcnt vmcnt(0)" ::: "memory");
  __syncthreads();
  if (threadIdx.x == 0) {
    unsigned* bar = b.bar;
    __builtin_amdgcn_s_waitcnt(0);
    unsigned nloc = b.st[0], nx = b.st[1];
    if (nloc == 0u) { xcd_barrier_complete(bar, b.x, nloc, nx); b.st[0] = nloc; b.st[1] = nx; }
    const unsigned old = xb_add(&bar[XB_XSUB(b.x)], 1u);
    const unsigned gen = old / nloc;
    if (old + 1u == (gen + 1u) * nloc) {
      __builtin_amdgcn_fence(__ATOMIC_RELEASE, "agent");
      asm volatile("s_waitcnt vmcnt(0)" ::: "memory");
      const unsigned og = xb_add(&bar[XB_TOP], 1u);
      const unsigned tg = og / nx;
      if (og + 1u == (tg + 1u) * nx) xb_add(&bar[XB_TOPGEN], 1u);
      else XB_SPIN(xb_ld(&bar[XB_TOPGEN]) == tg, bar);
      __builtin_amdgcn_fence(__ATOMIC_ACQUIRE, "agent");
      xb_add(&bar[XB_XGEN(b.x)], 1u);
      asm volatile("s_waitcnt vmcnt(0)" ::: "memory");
    } else {
      XB_SPIN(xb_ld(&bar[XB_XGEN(b.x)]) == gen, bar);
      __builtin_amdgcn_fence(__ATOMIC_ACQUIRE, "agent");
      asm volatile("s_waitcnt vmcnt(0)" ::: "memory");
    }
  }
  __syncthreads();
}
template <class F>
DI void tconv(LAS float* tile, bf16_t* dst, int ldd, int Nd, int K, F f, int cu, int ncu) {
  int tid = threadIdx.x; asm volatile("" : "+v"(tid)); const int ntk = K / 64, ntot = (Nd / 64) * ntk;
  for (int t = cu; t < ntot; t += ncu) {
    const int n0 = (t / ntk) * 64, k0 = (t % ntk) * 64;
#pragma unroll
    for (int i = 0; i < 8; ++i) { const int e = tid + i * 512, kk = e >> 6, nn = e & 63; tile[kk * 65 + nn] = f(k0 + kk, n0 + nn); }
    __syncthreads();
    { const int n = tid >> 3, kc = (tid & 7) * 8; float v[8];
#pragma unroll
      for (int j = 0; j < 8; ++j) v[j] = tile[(kc + j) * 65 + n];
      *(u32x4*)(dst + (size_t)(n0 + n) * ldd + k0 + kc) = pack8(v); }
    __syncthreads();
  }
}
DI int win_src(int n) {
  if (n < NG1 && pg8::g1a_perm_tile(n >> 8)) { const int ct = n & 255; n = (n & ~255) + ((ct >> 5) & 3) * 64 + (ct >> 7) * 32 + (ct & 31); }
  if (n < 3072) { if (n < 512) return n; if (n < 1024) return 1952 + (n - 512); if (n < 2560) return 2720 + (n - 1024); return 7328 + (n - 2560); }
  if (n < NG1) { const int c = n - 3072;
    if (c < 512) return 512 + c; if (c < 1024) return 1024 + (c - 512); if (c < 1152) return 2464 + (c - 1024); if (c < 1280) return 2592 + (c - 1152);
    if (c < 2816) return 4256 + (c - 1280); if (c < 4352) return 5792 + (c - 2816); if (c < 4608) return 1536 + (c - 4352); if (c < 4736) return 1792 + (c - 4608);
    if (c < 4768) return 1920 + (c - 4736); return -1; }
  return 7840 + (n - NG1);
}

DI u32x4 ldraw(const bf16_t* src, bool act) { u32x4 raw = (u32x4){0u, 0u, 0u, 0u}; if (act) raw = *(const u32x4*)src; return raw; }
template <int LPH>
DI void seg_norm(const bf16_t* src, bf16_t* dst, bool act, const float* gain, float post, float* vout, const u32x4* pre = nullptr, float inscale = 1.0f) {
  float v[8]; u32x4 raw; if (pre) raw = *pre; else raw = ldraw(src, act); unpack8(raw, v);
#pragma unroll
  for (int i = 0; i < 8; ++i) v[i] *= inscale;
  float ss = 0.f;
#pragma unroll
  for (int i = 0; i < 8; ++i) ss += v[i] * v[i];
#pragma unroll
  for (int o = 1; o < LPH; o <<= 1) ss += __shfl_xor(ss, o);
  const float r = rsqrtf(ss * (1.0f / (LPH * 8)) + EPS) * post;
#pragma unroll
  for (int i = 0; i < 8; ++i) v[i] = v[i] * r * (act ? gain[i] : 0.f);
  if (vout) {
#pragma unroll
    for (int i = 0; i < 8; ++i) vout[i] = v[i];
  } else if (act) *(u32x4*)dst = pack8(v);
}
DI void rope4(float* v, int lane4, const float* cs  , const float* sn  ) {
  const int jb = (lane4 & 1) * 8;
#pragma unroll
  for (int i = 0; i < 8; ++i) {
    const float partner = __shfl_xor(v[i], 2);
    const float c = cs[jb + i], s = sn[jb + i];
    v[i] = (lane4 < 2) ? (v[i] * c - partner * s) : (v[i] * c + partner * s);
  }
}


#define AT_SB __builtin_amdgcn_sched_barrier(0)
template <int NS, int KP>
DI void attn_qk(f32x16 (&st)[2], const bf16x8 (&qf)[NS], const LAS unsigned char* kbl  ) {
#pragma unroll
  for (int i = 0; i < 16; ++i) { st[0][i] = 0.f; st[1][i] = 0.f; }
  bf16x8 a0 = *(const LAS bf16x8*)(kbl), a1 = *(const LAS bf16x8*)(kbl + 32 * KP);
#pragma unroll
  for (int s = 0; s < NS; ++s) {
    bf16x8 n0 = a0, n1 = a1;
    if (s + 1 < NS) { n0 = *(const LAS bf16x8*)(kbl + 32 * (s + 1)); n1 = *(const LAS bf16x8*)(kbl + 32 * KP + 32 * (s + 1)); }
    AT_SB;
    st[0] = __builtin_amdgcn_mfma_f32_32x32x16_bf16(a0, qf[s], st[0], 0, 0, 0);
    st[1] = __builtin_amdgcn_mfma_f32_32x32x16_bf16(a1, qf[s], st[1], 0, 0, 0);
    AT_SB;
    a0 = n0; a1 = n1;
  }
}
template <int NDV, int VP>
DI void attn_pv_load0(s16x4 (&l0)[NDV], s16x4 (&h0)[NDV], LAS unsigned char* vbl) {
#pragma unroll
  for (int d = 0; d < NDV; ++d) {
    l0[d] = __builtin_bit_cast(s16x4, __builtin_amdgcn_ds_read_tr16_b64_v4i16((LAS s16x4*)(vbl + d * 64)));
    h0[d] = __builtin_bit_cast(s16x4, __builtin_amdgcn_ds_read_tr16_b64_v4i16((LAS s16x4*)(vbl + 8 * VP + d * 64))); }
}
template <int NDV, int VP, bool PRE>
DI void attn_pv(f32x16 (&o)[NDV], const u32x4 (&pfw)[4], LAS unsigned char* vbl  , s16x4 (&l0)[NDV], s16x4 (&h0)[NDV]) {
  s16x4 l1[NDV], h1[NDV];
#define AT_LD(l, h, b) _Pragma("unroll") for (int d = 0; d < NDV; ++d) { \
    l[d] = __builtin_bit_cast(s16x4, __builtin_amdgcn_ds_read_tr16_b64_v4i16((LAS s16x4*)(vbl + (16 * (b)) * VP + d * 64))); \
    h[d] = __builtin_bit_cast(s16x4, __builtin_amdgcn_ds_read_tr16_b64_v4i16((LAS s16x4*)(vbl + (16 * (b) + 8) * VP + d * 64))); }
#define AT_MM(l, h, b) { const bf16x8 _pf = __builtin_bit_cast(bf16x8, pfw[b]); _Pragma("unroll") for (int d = 0; d < NDV; ++d) \
    o[d] = __builtin_amdgcn_mfma_f32_32x32x16_bf16(__builtin_shufflevector(l[d], h[d], 0, 1, 2, 3, 4, 5, 6, 7), _pf, o[d], 0, 0, 0); }
  if (!PRE) { AT_LD(l0, h0, 0); }
  AT_LD(l1, h1, 1); AT_SB; AT_MM(l0, h0, 0); AT_SB;
  AT_LD(l0, h0, 2); AT_SB; AT_MM(l1, h1, 1); AT_SB;
  AT_LD(l1, h1, 3); AT_SB; AT_MM(l0, h0, 2); AT_SB;
  AT_MM(l1, h1, 3); AT_SB;
#undef AT_LD
#undef AT_MM
}
template <int DQK, int DV, bool BIAS, bool MASK, bool BMM>
DI void attn_item(LAS unsigned char* lds, const bf16_t* Q, int pq, const bf16_t* K, int pk, const bf16_t* V, int pv, bf16_t* O, int po,
                  float* lse, int lse_stride, int q0, int L, int W, float slope2, float m_init, float l_init) {
  constexpr int KP = DQK * 2 + 16, VP = DV * 2 + 64, KBYTES = 64 * KP, VBYTES = 64 * VP, BUF = KBYTES + VBYTES;
  constexpr int KC8 = DQK / 8, VC8 = DV / 8, KCH = 64 * KC8, VCH = 64 * VC8, KPT = (KCH + 511) / 512, VPT = (VCH + 511) / 512;
  constexpr int NS = DQK / 16, NDV = DV / 32;
  int tid = threadIdx.x; asm volatile("" : "+v"(tid));
  const int wid = tid >> 6, lane = tid & 63, r = lane & 31, h = lane >> 5;
  const int qw0 = q0 + 32 * wid, qi = qw0 + r;
  bf16x8 qf[NS];
#pragma unroll
  for (int s = 0; s < NS; ++s) qf[s] = *(const bf16x8*)(Q + (size_t)qi * pq + 16 * s + 8 * h);
  f32x16 o[NDV];
#pragma unroll
  for (int d = 0; d < NDV; ++d)
#pragma unroll
    for (int i = 0; i < 16; ++i) o[d][i] = 0.f;
  float m = m_init, lsum = (h == 0) ? l_init : 0.f;
  u32x4 kext[2]; unsigned cw1 = 0u, cw2 = 0u;
  if (BMM) {
    const unsigned one = 0x3F80u;
#pragma unroll
    for (int b2 = 0; b2 < 2; ++b2) { const unsigned jb = cvt_pk((float)(32 * b2 + r), 0.f) & 0xffffu;
      kext[b2] = (h == 0) ? (u32x4){one | (one << 16), one | (jb << 16), jb | (jb << 16), 0u} : (u32x4){0u, 0u, 0u, 0u}; }
    const unsigned c_hi = cvt_pk(slope2, 0.f) & 0xffffu; const float r1 = slope2 - __uint_as_float(c_hi << 16);
    const unsigned c_mid = cvt_pk(r1, 0.f) & 0xffffu; const float r2 = r1 - __uint_as_float(c_mid << 16); const unsigned c_lo = cvt_pk(r2, 0.f) & 0xffffu;
    cw1 = c_hi << 16; cw2 = c_mid | (c_lo << 16);
  }
  const int klo = (q0 - W > 0 ? q0 - W : 0) >> 6;
  const int khi = ((q0 + 256 + W < L ? q0 + 256 + W : L) + 63) >> 6;
  const int nt = khi - klo;
  u32x4 kreg[KPT], vreg[VPT];
#define AT_GLOAD(kt) do { const int _k0 = (kt) * 64; \
    _Pragma("unroll") for (int _i = 0; _i < KPT; ++_i) { const int _c = tid + _i * 512; if (_c < KCH) { const int _row = _c / KC8, _cc = _c - _row * KC8; kreg[_i] = *(const u32x4*)(K + (size_t)(_k0 + _row) * pk + _cc * 8); } } \
    _Pragma("unroll") for (int _i = 0; _i < VPT; ++_i) { const int _c = tid + _i * 512; if (_c < VCH) { const int _row = _c / VC8, _cc = _c - _row * VC8; vreg[_i] = *(const u32x4*)(V + (size_t)(_k0 + _row) * pv + _cc * 8); } } } while (0)
#define AT_LSTORE(ks, vs_) do { LAS unsigned char* _kb = lds + (ks) * KBYTES; LAS unsigned char* _vb = lds + 2 * KBYTES + (vs_) * VBYTES; \
    _Pragma("unroll") for (int _i = 0; _i < KPT; ++_i) { const int _c = tid + _i * 512; if (_c < KCH) { const int _row = _c / KC8, _cc = _c - _row * KC8; *(LAS u32x4*)(_kb + _row * KP + _cc * 16) = kreg[_i]; } } \
    _Pragma("unroll") for (int _i = 0; _i < VPT; ++_i) { const int _c = tid + _i * 512; if (_c < VCH) { const int _row = _c / VC8, _cc = _c - _row * VC8; *(LAS u32x4*)(_vb + _row * VP + _cc * 16) = vreg[_i]; } } } while (0)
#define AT_PV(vstage) do { s16x4 _l0[NDV], _h0[NDV]; attn_pv<NDV, VP, false>(o, pfw, lds + 2 * KBYTES + (vstage) * VBYTES + vlane_off, _l0, _h0); } while (0)
  AT_GLOAD(klo); AT_LSTORE(0, 0); __syncthreads();
  const int i16 = lane & 15, q4 = i16 >> 2, p4 = i16 & 3, blk = (lane >> 4) & 1;
  const int vlane_off = (4 * h + q4) * VP + (16 * blk + 4 * p4) * 2;
  const bool lag = wid >= 4;
  u32x4 pfw[4]; bool pend = false; int pend_vs = 0, vs = 0;
#pragma unroll
  for (int i = 0; i < 4; ++i) pfw[i] = (u32x4){0u, 0u, 0u, 0u};
  for (int t = 0; t < nt; ++t) {
    const int k0 = (klo + t) * 64;
    if (t + 1 < nt) AT_GLOAD(klo + t + 1);
    const bool active = (k0 + 63 >= qw0 - W) && (k0 <= qw0 + 31 + W);
    if (pend) { AT_PV(pend_vs); pend = false; }
    if (active) {
      LAS unsigned char* kb = lds + (t & 1) * KBYTES;
      f32x16 st[2];
      attn_qk<NS, KP>(st, qf, kb + r * KP + 16 * h);
      const int side = !BMM ? 0 : (k0 + 63 < qw0) ? 1 : (k0 > qw0 + 31) ? -1 : 0;
      if (BMM && side != 0) {
        const float av = (side > 0 ? -slope2 : slope2) * (float)(qi - k0);
        const unsigned a_hi = cvt_pk(av, 0.f) & 0xffffu; const float q1 = av - __uint_as_float(a_hi << 16);
        const unsigned a_mid = cvt_pk(q1, 0.f) & 0xffffu; const float q2 = q1 - __uint_as_float(a_mid << 16); const unsigned a_lo = cvt_pk(q2, 0.f) & 0xffffu;
        const unsigned sg = side > 0 ? 0u : 0x80008000u;
        const u32x4 qe = {a_hi | (a_mid << 16), a_lo | ((cw1 ^ sg) & 0xffff0000u), cw2 ^ sg, 0u};
        const bf16x8 qeb = __builtin_bit_cast(bf16x8, qe);
        st[0] = __builtin_amdgcn_mfma_f32_32x32x16_bf16(__builtin_bit_cast(bf16x8, kext[0]), qeb, st[0], 0, 0, 0);
        st[1] = __builtin_amdgcn_mfma_f32_32x32x16_bf16(__builtin_bit_cast(bf16x8, kext[1]), qeb, st[1], 0, 0, 0);
      }
      s16x4 vl0[NDV], vh0[NDV];
      if (!lag) attn_pv_load0<NDV, VP>(vl0, vh0, lds + 2 * KBYTES + vs * VBYTES + vlane_off);
      if ((BIAS || MASK) && !(BMM && side != 0)) {
        const float basef = (float)(qi - k0 - 4 * h), Wf = (float)W;
#pragma unroll
        for (int b2 = 0; b2 < 2; ++b2)
#pragma unroll
          for (int i = 0; i < 16; ++i) {
            float s = st[b2][i];
            const float df = basef - (float)(32 * b2 + (i & 3) + 8 * (i >> 2));
            if (BIAS) s = s - slope2 * fabsf(df);
            if (MASK) s = (fabsf(df) > Wf) ? -INFINITY : s;
            st[b2][i] = s; }
      }
      float ps = 0.f;
#pragma unroll
      for (int b2 = 0; b2 < 2; ++b2)
#pragma unroll
        for (int i = 0; i < 16; ++i) { const float p = fexp2(st[b2][i]); st[b2][i] = p; ps += p; }
      lsum += ps;
#pragma unroll
      for (int b2 = 0; b2 < 2; ++b2)
#pragma unroll
        for (int s2 = 0; s2 < 2; ++s2) {
          u32x4 pw; pw.x = cvt_pk(st[b2][8 * s2 + 0], st[b2][8 * s2 + 1]); pw.y = cvt_pk(st[b2][8 * s2 + 2], st[b2][8 * s2 + 3]);
          pw.z = cvt_pk(st[b2][8 * s2 + 4], st[b2][8 * s2 + 5]); pw.w = cvt_pk(st[b2][8 * s2 + 6], st[b2][8 * s2 + 7]);
          pfw[b2 * 2 + s2] = pw;
        }
      if (lag) { pend = true; pend_vs = vs; } else { attn_pv<NDV, VP, true>(o, pfw, lds + 2 * KBYTES + vs * VBYTES + vlane_off, vl0, vh0); }
    }
    const int vsn = vs == 2 ? 0 : vs + 1;
    if (t + 1 < nt) AT_LSTORE((t + 1) & 1, vsn);
    __syncthreads();
    vs = vsn;
  }
  if (pend) { AT_PV(pend_vs); }
#undef AT_PV
#undef AT_GLOAD
#undef AT_LSTORE
  const float lt = lsum + __shfl_xor(lsum, 32); const float inv = 1.0f / lt;
#pragma unroll
  for (int d = 0; d < NDV; ++d)
#pragma unroll
    for (int g4 = 0; g4 < 4; ++g4) {
      u32x2 w; w.x = cvt_pk(o[d][4 * g4] * inv, o[d][4 * g4 + 1] * inv); w.y = cvt_pk(o[d][4 * g4 + 2] * inv, o[d][4 * g4 + 3] * inv);
      *(u32x2*)(O + (size_t)qi * po + 32 * d + 8 * g4 + 4 * h) = w;
    }
  if (lse != nullptr && h == 0) lse[(size_t)qi * lse_stride] = m + __log2f(lt);
}


#ifdef DBG
#define WS_DBG (512 * 1024)
DI void dbg_max(unsigned* p, float e) { if (!(e >= 0.f)) e = 1e9f; atomicMax(p, __float_as_uint(e)); }
DI unsigned dbg_hash(unsigned x) { x ^= x >> 16; x *= 0x7feb352du; x ^= x >> 15; x *= 0x846ca68bu; x ^= x >> 16; return x; }
template <int DQK, int DV>
DI float dbg_attn_row(LAS float* sc, const bf16_t* Q, int pq, const bf16_t* K, int pk, const bf16_t* V, int pv, const bf16_t* O, int po,
                      int qi, int L, int W, float slope2, float m_init, float l_init, int lane) {
  float mx = m_init;
  for (int j = lane; j < L; j += 64) {
    int d = qi - j; d = d < 0 ? -d : d; float s = -INFINITY;
    if (d <= W) { s = 0.f; for (int c = 0; c < DQK; ++c) s += bf2f(Q[(size_t)qi * pq + c]) * bf2f(K[(size_t)j * pk + c]); s -= slope2 * (float)d; }
    sc[j] = s; mx = fmaxf(mx, s);
  }
  for (int o = 1; o < 64; o <<= 1) mx = fmaxf(mx, __shfl_xor(mx, o));
  float sum = 0.f;
  for (int j = lane; j < L; j += 64) { const float p = exp2f(sc[j] - mx); sc[j] = p; sum += p; }
  for (int o = 1; o < 64; o <<= 1) sum += __shfl_xor(sum, o);
  sum += l_init * exp2f(m_init - mx);
  float emax = 0.f, rmax = 0.f;
  for (int dv = lane; dv < DV; dv += 64) {
    float acc = 0.f; for (int j = 0; j < L; ++j) acc += sc[j] * bf2f(V[(size_t)j * pv + dv]);
    acc /= sum; const float got = bf2f(O[(size_t)qi * po + dv]);
    emax = fmaxf(emax, fabsf(got - acc)); rmax = fmaxf(rmax, fabsf(acc));
  }
  for (int o = 1; o < 64; o <<= 1) { emax = fmaxf(emax, __shfl_xor(emax, o)); rmax = fmaxf(rmax, __shfl_xor(rmax, o)); }
  return emax / (rmax + 1e-3f);
}
#endif
#define WSP(T, off) ((T*)(ap->ws + (off)))
#define ROPE WSP(float, WS_ROPE)
#define WIN WSP(bf16_t, WS_WIN)
#define WMLA WSP(bf16_t, WS_WMLA)
#define WMEM WSP(bf16_t, WS_WMEM)
#define WBR WSP(bf16_t, WS_WBR)
#define WOUT WSP(bf16_t, WS_WOUT)
#define MN WSP(bf16_t, WS_MN)
#define MKV WSP(bf16_t, WS_MKV)
#define LSE WSP(float, WS_LSE)
#define H WSP(bf16_t, WS_H)
#define QB WSP(bf16_t, WS_QB)
#define KVB WSP(bf16_t, WS_KVB)
#define MLA WSP(bf16_t, WS_MLA)
#define BK WSP(bf16_t, WS_BK)
#define GATE WSP(bf16_t, WS_GATE)
typedef const __attribute__((address_space(4))) Args* CArgsP;
__global__ void __launch_bounds__(512, 2) mega(Args args_unused) {
  extern __shared__ __attribute__((aligned(16))) unsigned char shm_raw[];
  LAS unsigned char* lds = (LAS unsigned char*)shm_raw;
  const int ph_lo = ((CArgsP)__builtin_amdgcn_kernarg_segment_ptr())->ph_lo, ph_hi = ((CArgsP)__builtin_amdgcn_kernarg_segment_ptr())->ph_hi;
  volatile LAS unsigned* xb_st = (volatile LAS unsigned*)(lds + 131072);
  if (threadIdx.x == 0) { xb_st[0] = 0u; xb_st[1] = 0u; }
  __syncthreads();
  const XcdBarrier xbar = xcd_barrier_post((unsigned*)(((CArgsP)__builtin_amdgcn_kernarg_segment_ptr())->ws), xb_st);
  for (int ph = ph_lo; ph < ph_hi; ++ph) {
    CArgsP ap0 = (CArgsP)__builtin_amdgcn_kernarg_segment_ptr(); int phv = ph;
    asm volatile("" : "+s"(ap0), "+s"(phv));
#define PHASE_AP CArgsP ap = ap0; asm volatile("" : "+s"(ap));
    int tid = threadIdx.x; asm volatile("" : "+v"(tid));
    const int wid = tid >> 6, lane = tid & 63;
    int G = gridDim.x, cu = blockIdx.x; asm volatile("" : "+s"(G), "+s"(cu));
    const int l = phv / 31, idx = phv % 31;
    if (idx >= 1 && (idx - 1) % 10 == 2) continue;
    if (idx == 0) {
      PHASE_AP
      LAS float* tile = (LAS float*)lds;
      const int dmask = ap->pad;
      if (dmask & 1) { const float* w = ap->in[5] + (size_t)l * DM * NIN;
        tconv(tile, WIN, DM, NWIN, DM, [&](int k, int n) { const int c = win_src(n); return c < 0 ? 0.f : w[(size_t)k * NIN + c]; }, cu, G); }
      if (dmask & 2) { const float* gcq = ap->in[10] + l * 256; const float* gckv = ap->in[11] + l * 128;
        const float* wq = ap->in[12] + (size_t)l * 256 * 384; const float* wk = ap->in[13] + (size_t)l * 128 * 768;
        tconv(tile, WMLA, 384, PMLA, 384, [&](int k, int n) { if (n < 384) return k < 256 ? wq[k * 384 + n] * gcq[k] : 0.f; if (n < 1152) return k >= 256 ? wk[(k - 256) * 768 + (n - 384)] * gckv[k - 256] : 0.f; return 0.f; }, cu, G); }
      if (dmask & 4) { const float* w = ap->in[22] + (size_t)l * DM * 1024;
        tconv(tile, WMEM, DM, 1024, DM, [&](int k, int n) { return w[(size_t)k * 1024 + n]; }, cu, G); }
      if (dmask & 8) { const float* w = ap->in[26] + (size_t)l * 5 * 512 * 1024;
        tconv(tile, WBR, 512, 5120, 512, [&](int k, int n) { return w[((size_t)(n >> 10) * 512 + k) * 1024 + (n & 1023)]; }, cu, G); }
      if (dmask & 16) { const float* w = ap->in[27] + (size_t)l * DM * DM;
        tconv(tile, WOUT, DM, DM, DM, [&](int k, int n) { return w[(size_t)k * DM + n]; }, cu, G); }
      if (l == 0) {
        const float invf[16] = {1.0f, 0.5623413251903491f, 0.31622776601683794f, 0.1778279410038923f, 0.1f, 0.05623413251903491f, 0.03162277660168379f, 0.01778279410038923f,
                                0.01f, 0.005623413251903491f, 0.0031622776601683794f, 0.001778279410038923f, 0.001f, 0.0005623413251903491f, 0.00031622776601683794f, 0.0001778279410038923f};
        for (int e = cu * 512 + tid; e < 8192 * 16; e += G * 512) {
          const int pos = e >> 4, j = e & 15; float iv = invf[0];
#pragma unroll
          for (int q = 1; q < 16; ++q) iv = (j == q) ? invf[q] : iv;
          const float ang = (float)pos * iv;
          const double rev = (double)ang * 0.15915494309189535; const float fr = (float)(rev - __builtin_rint(rev));
          ROPE[pos * 32 + j] = __builtin_amdgcn_cosf(fr); ROPE[pos * 32 + 16 + j] = __builtin_amdgcn_sinf(fr);
        }
      }
    } else {
      const int u = (idx - 1) / 10, p = (idx - 1) % 10;
      const int S = (u == 0) ? 4096 : 8192, nseq = (u == 0) ? 4 : 2, nmem = nseq * 256;
#define XIN ((l == 0) ? ((u == 0) ? ap->in[0] : ap->in[1] + (size_t)(u - 1) * TU * DM) : ap->out + (size_t)u * TU * DM)
#define XOUT (ap->out + (size_t)u * TU * DM)
#define MEMIN ((u == 0) ? ap->in[2] : ap->in[3] + (size_t)(u - 1) * 512 * DM)
      if (p == 0) {
        PHASE_AP
        const float* xin = XIN; const float* memin = MEMIN;
        const float* g1 = ap->in[4] + l * DM; const float* g2 = ap->in[21] + l * DM;
        for (int row = cu * 8 + wid; row < TU + nmem; row += G * 8) {
          const bool ism = row >= TU; const float* src = ism ? memin + (size_t)(row - TU) * DM : xin + (size_t)row * DM;
          const float* gg = ism ? g2 : g1; bf16_t* dst = ism ? MN + (size_t)(row - TU) * DM : H + (size_t)row * DM;
          f32x4 v[4]; float ss = 0.f;
#pragma unroll
          for (int i = 0; i < 4; ++i) { v[i] = *(const f32x4*)(src + i * 256 + lane * 4); ss += v[i][0] * v[i][0] + v[i][1] * v[i][1] + v[i][2] * v[i][2] + v[i][3] * v[i][3]; }
#pragma unroll
          for (int o = 1; o < 64; o <<= 1) ss += __shfl_xor(ss, o);
          const float rr = rsqrtf(ss * (1.0f / DM) + EPS);
#pragma unroll
          for (int i = 0; i < 4; ++i) { const f32x4 gv = *(const f32x4*)(gg + i * 256 + lane * 4);
            u32x2 w; w.x = cvt_pk(v[i][0] * rr * gv[0], v[i][1] * rr * gv[1]); w.y = cvt_pk(v[i][2] * rr * gv[2], v[i][3] * rr * gv[3]);
            *(u32x2*)(dst + i * 256 + lane * 4) = w; }
        }
      } else if (p == 1) {
        PHASE_AP
        { pg8::GridOrder S_; S_.init(H, DM, WIN, DM, TU, NG1, G, cu); pg8::EpiG1a E{QB, KVB, ap->in[6] + l * 64, ap->in[16] + l * 64, ap->in[19] + l * 64, ap->in[7] + l * 64, ap->in[17] + l * 64, ap->in[20] + l * 64}; pg8::gemm_phase(lds, pg8::Gemm{DM, DM, DM}, S_, E); }
        { pg8::GridOrder S_; S_.init(MN, DM, WMEM, DM, nmem, 1024, G, (cu + 64) % G); pg8::EpiPlain E{MKV, PMKV}; pg8::gemm_phase(lds, pg8::Gemm{DM, DM, DM}, S_, E); }
      } else if (p == 2) {
        PHASE_AP
        const float sc64 = 0.125f * LOG2E, sc128 = 0.08838834764831845f * LOG2E;
        const float* a_qn = ap->in[6] + l * 64; const float* a_kn = ap->in[7] + l * 64; const float* b_cqn = ap->in[10] + l * 256; const float* b_ckvn = ap->in[11] + l * 128;
        const float* b_kn = ap->in[15] + l * 96; const float* c_qn = ap->in[16] + l * 64; const float* c_kn = ap->in[17] + l * 64; const float* d_qn = ap->in[19] + l * 64;
        const float* d_kn = ap->in[20] + l * 64; const float* m_qn = ap->in[23] + l * 128; const float* m_kn = ap->in[24] + l * 128;
        const int c8 = (lane & 7) * 8, c16 = (lane & 15) * 8;
        for (int row = cu * 8 + wid; row < TU + nmem; row += G * 8) {
          if (row >= TU) { bf16_t* pk_ = MKV + (size_t)(row - TU) * PMKV + lane * 8; seg_norm<16>(pk_, pk_, true, m_kn + c16, 1.f, nullptr); continue; }
          bf16_t* qb = QB + (size_t)row * PQ + lane * 8; bf16_t* kv = KVB + (size_t)row * PKV + lane * 8;
          const u32x4 r5 = ldraw(qb + QC_MQ, true), r11 = ldraw(kv + KC_CQ, lane < 32), r12 = ldraw(kv + KC_CKV, lane < 16), r13 = ldraw(kv + KC_KR, lane < 4);
          seg_norm<16>(nullptr, qb + QC_MQ, true, m_qn + c16, sc128, nullptr, &r5);
          seg_norm<32>(nullptr, kv + KC_CQ, lane < 32, b_cqn + (lane & 31) * 8, 1.f, nullptr, &r11);
          seg_norm<16>(nullptr, kv + KC_CKV, lane < 16, b_ckvn + c16, 1.f, nullptr, &r12);
          { float v[8]; seg_norm<4>(nullptr, nullptr, lane < 4, b_kn + 64 + (lane & 3) * 8, 1.f, v, &r13);
            const float* rp = ROPE + (size_t)(row % S) * 32; rope4(v, lane & 3, rp, rp + 16);
            if (lane < 4) *(u32x4*)(kv + KC_KR) = pack8(v); }
        }
      } else if (p == 3) {
        PHASE_AP
        pg8::GridOrder S_; S_.init(KVB + KC_CQ, PKV, WMLA, 384, TU, PMLA, G, cu); pg8::EpiPlain E{MLA, PMLA}; pg8::gemm_phase(lds, pg8::Gemm{PKV, 384, 384}, S_, E);
      } else if (p == 4) {
        PHASE_AP
        const float scb = 0.10206207261596575f * LOG2E, sc128 = 0.08838834764831845f * LOG2E;
        const float* b_qn = ap->in[14] + l * 96; const float* b_kn = ap->in[15] + l * 96; const float* m_qn = ap->in[23] + l * 128; const float* m_kn = ap->in[24] + l * 128;
        const int c16 = (lane & 15) * 8;
        for (int row = cu * 8 + wid; row < TU + nmem; row += G * 8) {
          if (row >= TU) { bf16_t* pk_ = MKV + (size_t)(row - TU) * PMKV + lane * 8; seg_norm<16>(pk_, pk_, true, m_kn + c16, 1.f, nullptr); continue; }
          bf16_t* ml = MLA + (size_t)row * PMLA; bf16_t* bk = BK + (size_t)row * PBK; const bf16_t* kvrow = KVB + (size_t)row * PKV; bf16_t* pmq = QB + (size_t)row * PQ + QC_MQ + lane * 8;
          const float* rp = ROPE + (size_t)(row % S) * 32;
          const int hd8 = (lane >> 3) & 3, ch8 = lane & 7, hd4 = (lane >> 2) & 3, ch4 = lane & 3;
          bf16_t* pqn = ml + hd8 * 96 + ch8 * 8; bf16_t* pqr = ml + hd4 * 96 + 64 + ch4 * 8; bf16_t* pv_ = ml + 384 + (lane >> 4) * 192 + 64 + c16;
          const u32x4 rcq = ldraw(kvrow + KC_CQ + lane * 8, lane < 32), rckv = ldraw(kvrow + KC_CKV + lane * 8, lane < 16), rkr = ldraw(kvrow + KC_KR + ch4 * 8, lane < 16), rmq = ldraw(pmq, true),
                      q0r = ldraw(pqn, lane < 32), q1r = ldraw(pqr, lane < 16), q2r = ldraw(ml + 384 + hd8 * 192 + ch8 * 8, lane < 32), rvv = ldraw(pv_, true);
          float sq = 0.f, skv = 0.f;
          { float t8[8]; unpack8(rcq, t8);
#pragma unroll
            for (int i = 0; i < 8; ++i) sq += t8[i] * t8[i];
            unpack8(rckv, t8);
#pragma unroll
            for (int i = 0; i < 8; ++i) skv += t8[i] * t8[i]; }
#pragma unroll
          for (int o = 1; o < 64; o <<= 1) { sq += __shfl_xor(sq, o); skv += __shfl_xor(skv, o); }
          const float r_q = rsqrtf(sq * (1.0f / 256.0f) + EPS), r_kv = rsqrtf(skv * (1.0f / 128.0f) + EPS);
          seg_norm<8>(nullptr, pqn, lane < 32, b_qn + ch8 * 8, scb, nullptr, &q0r, r_q);
          { float v[8]; seg_norm<4>(nullptr, nullptr, lane < 16, b_qn + 64 + ch4 * 8, 1.f, v, &q1r, r_q);
            rope4(v, ch4, rp, rp + 16);
#pragma unroll
            for (int i = 0; i < 8; ++i) v[i] *= scb;
            if (lane < 16) *(u32x4*)pqr = pack8(v); }
          seg_norm<8>(nullptr, bk + hd8 * 96 + ch8 * 8, lane < 32, b_kn + ch8 * 8, 1.f, nullptr, &q2r, r_kv);
          { float v[8]; seg_norm<4>(nullptr, nullptr, lane < 16, b_kn + 64 + ch4 * 8, 1.f, v, &rkr);
            rope4(v, ch4, rp, rp + 16);
            if (lane < 16) *(u32x4*)(bk + hd4 * 96 + 64 + ch4 * 8) = pack8(v); }
          { float v[8]; unpack8(rvv, v);
#pragma unroll
            for (int i = 0; i < 8; ++i) v[i] *= r_kv;
            *(u32x4*)pv_ = pack8(v); }
          seg_norm<16>(nullptr, pmq, true, m_qn + c16, sc128, nullptr, &rmq);
        }
      } else if (p == 5) {
        PHASE_AP
        const int nqb = S / 256, per = nseq * nqb;
        const int nB = per * 4, nA = per * 8, nC = per * 8, nD = per * 24, nM = per * 4, ntot = nB + nA + nC + nD + nM;
        const float* sink = ap->in[18] + l * 8;
        const int BIGW = 1 << 28;
        float gq = fabsf((ap->in[6] + l * 64)[lane]), gk = fabsf((ap->in[7] + l * 64)[lane]);
#pragma unroll
        for (int o = 1; o < 64; o <<= 1) { gq = fmaxf(gq, __shfl_xor(gq, o)); gk = fmaxf(gk, __shfl_xor(gk, o)); }
        const float athr = 2.0f * (8.0f * gq * gk * 1.02f) + 104.0f;
        float gbq = fmaxf(fabsf((ap->in[14] + l * 96)[lane]), fabsf((ap->in[14] + l * 96)[64 + (lane & 31)])), gbk = fmaxf(fabsf((ap->in[15] + l * 96)[lane]), fabsf((ap->in[15] + l * 96)[64 + (lane & 31)]));
        float gcq = fabsf((ap->in[16] + l * 64)[lane]), gck = fabsf((ap->in[17] + l * 64)[lane]), gdq = fabsf((ap->in[19] + l * 64)[lane]), gdk = fabsf((ap->in[20] + l * 64)[lane]);
        float gmq = fmaxf(fabsf((ap->in[23] + l * 128)[lane]), fabsf((ap->in[23] + l * 128)[64 + lane])), gmk = fmaxf(fabsf((ap->in[24] + l * 128)[lane]), fabsf((ap->in[24] + l * 128)[64 + lane]));
#pragma unroll
        for (int o = 1; o < 64; o <<= 1) { gbq = fmaxf(gbq, __shfl_xor(gbq, o)); gbk = fmaxf(gbk, __shfl_xor(gbk, o)); gcq = fmaxf(gcq, __shfl_xor(gcq, o)); gck = fmaxf(gck, __shfl_xor(gck, o));
          gdq = fmaxf(gdq, __shfl_xor(gdq, o)); gdk = fmaxf(gdk, __shfl_xor(gdk, o)); gmq = fmaxf(gmq, __shfl_xor(gmq, o)); gmk = fmaxf(gmk, __shfl_xor(gmk, o)); }
        const float smA = 8.0f * gq * gk * (LOG2E * 1.02f), smB = 9.797959f * gbq * gbk * (LOG2E * 1.02f), smC = 8.0f * gcq * gck * (LOG2E * 1.02f),
                    smD = 8.0f * gdq * gdk * (LOG2E * 1.02f), smM = 11.313708f * gmq * gmk * (LOG2E * 1.02f);
        unsigned* qctr = (unsigned*)(ap->ws + 32768) + (l * 3 + u) * 64;
        volatile LAS unsigned* qslot = (volatile LAS unsigned*)(lds + 131072 + 16);
        for (;;) {
          __syncthreads();
          if (tid == 0) qslot[0] = atomicAdd(qctr, 1u);
          __syncthreads();
          const int it = (int)qslot[0];
          if (it >= ntot) break;
          int j = it;
          if (j < nB) {
            const int blk = j % nqb, hh = (j / nqb) % 4, b = j / (nqb * 4); const size_t r0 = (size_t)b * S;
            attn_item<96, 128, false, false, false>(lds, MLA + r0 * PMLA + hh * 96, PMLA, BK + r0 * PBK + hh * 96, PBK, MLA + r0 * PMLA + 384 + hh * 192 + 64, PMLA,
                               QB + r0 * PQ + QC_OB + hh * 128, PQ, nullptr, 0, blk * 256, S, BIGW, 0.f, 0.f, 0.f);
            continue; }
          j -= nB;
          if (j < nA) {
            const int blk = j % nqb, mm = (j / nqb) & 1, b = (j / (nqb * 2)) % nseq, hh = 3 - j / (nqb * 2 * nseq); const size_t r0 = (size_t)b * S;
            const float sn = exp2f(-2.0f * (hh + 1)), slope = sn * LOG2E; const float wf = athr / sn + 2.0f; const int Wa = wf > 1e8f ? BIGW : (int)wf;
            attn_item<64, 128, true, false, true>(lds, QB + r0 * PQ + QC_AQ + mm * 256 + hh * 64, PQ, KVB + r0 * PKV + KC_AK + mm * 256 + hh * 64, PKV, KVB + r0 * PKV + KC_AV + hh * 128, PKV,
                               QB + r0 * PQ + QC_OA + mm * 512 + hh * 128, PQ, nullptr, 0, blk * 256, S, Wa, slope, 0.f, 0.f);
            continue; }
          j -= nA;
          if (j < nC) {
            const int blk = j % nqb, hq = (j / nqb) % 8, b = j / (nqb * 8), kvh = hq >> 2; const size_t r0 = (size_t)b * S;
            const float slope = exp2f(-(float)(hq + 1)) * LOG2E; const float sk2 = sink[hq] * LOG2E, mC = fmaxf(smC, sk2);
            attn_item<64, 64, true, true, false>(lds, QB + r0 * PQ + QC_CQ + hq * 64, PQ, KVB + r0 * PKV + KC_CK + kvh * 64, PKV, KVB + r0 * PKV + KC_CV + kvh * 64, PKV,
                              QB + r0 * PQ + QC_CQ + hq * 64, PQ, nullptr, 0, blk * 256, S, 128, slope, 0.f, exp2f(sk2));
            continue; }
          j -= nC;
          if (j < nD) {
            const int blk = j % nqb, gh = (j / nqb) % 24, b = j / (nqb * 24), gg = gh >> 3, hh = gh & 7;
            const int dil = gg == 0 ? 1 : gg == 1 ? 4 : 16; const int Ls = S / dil, nbr = Ls / 256, res = blk / nbr, qbk = blk % nbr;
            const size_t r0 = (size_t)b * S + res; const float slope = exp2f(-(float)(hh + 1)) * LOG2E * (float)dil;
            attn_item<64, 64, true, true, false>(lds, QB + r0 * PQ + QC_DQ + gg * 512 + hh * 64, PQ * dil, KVB + r0 * PKV + KC_DK + gg * 512 + hh * 64, PKV * dil, KVB + r0 * PKV + KC_DV + gg * 512 + hh * 64, PKV * dil,
                              QB + r0 * PQ + QC_DQ + gg * 512 + hh * 64, PQ * dil, LSE + r0 * 24 + gg * 8 + hh, 24 * dil, qbk * 256, Ls, 64, slope, 0.f, 0.f);
            continue; }
          j -= nD;
          { const int blk = j % nqb, hh = (j / nqb) % 4, b = j / (nqb * 4); const size_t r0 = (size_t)b * S;
            attn_item<128, 128, false, false, false>(lds, QB + r0 * PQ + QC_MQ + hh * 128, PQ, MKV + (size_t)b * 256 * PMKV + hh * 128, PMKV, MKV + (size_t)b * 256 * PMKV + 512 + hh * 128, PMKV,
                                QB + r0 * PQ + QC_MQ + hh * 128, PQ, nullptr, 0, blk * 256, 256, BIGW, 0.f, 0.f, 0.f); }
        }
      } else if (p == 6) {
        PHASE_AP
        const float* lf = ap->in[8] + l * 256; const float* a_hn = ap->in[9] + l * 128;
        float d01 = lf[lane] * lf[64 + lane], d23 = lf[128 + lane] * lf[192 + lane];
#pragma unroll
        for (int o = 1; o < 64; o <<= 1) { d01 += __shfl_xor(d01, o); d23 += __shfl_xor(d23, o); }
        const float lam_init = 0.8f - 0.6f * expf(-0.3f * (float)l);
        const float lam = expf(d01) - expf(d23) + lam_init;
        const int c16 = (lane & 15) * 8;
        for (int row = cu * 8 + wid; row < TU; row += G * 8) {
          bf16_t* qb = QB + (size_t)row * PQ;
          bf16_t* pA = qb + QC_OA + lane * 8; bf16_t* pD = qb + QC_DQ + lane * 8;
          const u32x4 ra0 = *(const u32x4*)pA, ra1 = *(const u32x4*)(pA + 512);
          { float a0[8], a1[8]; unpack8(ra0, a0); unpack8(ra1, a1);
            float ss = 0.f;
#pragma unroll
            for (int i = 0; i < 8; ++i) { a0[i] = a0[i] - lam * a1[i]; ss += a0[i] * a0[i]; }
#pragma unroll
            for (int o = 1; o < 16; o <<= 1) ss += __shfl_xor(ss, o);
            const float rr = rsqrtf(ss * (1.0f / 128.0f) + EPS) * (1.0f - lam_init);
#pragma unroll
            for (int i = 0; i < 8; ++i) a0[i] = a0[i] * rr * a_hn[c16 + i];
            *(u32x4*)pA = pack8(a0); }
        }
        __syncthreads();
        { pg8::GridOrder S_; S_.init(H, DM, WIN + (size_t)(NG1 + NZ) * DM, DM, TU, NGT, G, cu); pg8::EpiGate E{GATE, ap->in[25] + (size_t)l * 5 * DM}; pg8::gemm_phase(lds, pg8::Gemm{DM, DM, DM}, S_, E); }
      } else if (p == 7) {
        PHASE_AP
        pg8::GridOrder S_; S_.init(H, DM, WIN + (size_t)NG1 * DM, DM, TU, NZ, G, cu); pg8::EpiZ E{QB, LSE}; pg8::gemm_phase(lds, pg8::Gemm{DM, DM, DM}, S_, E);
      } else if (p == 8) {
        PHASE_AP
        pg8::MergeOrder S_{(const char*)QB, (const char*)WBR, (TU / 256) * 4, G, cu}; pg8::EpiMerge E{H, GATE, (ap->pad >> 8) & 31}; pg8::gemm_phase(lds, pg8::Gemm{PQ, 512, 512}, S_, E);
      } else {
        PHASE_AP
        const float* xin = XIN; float* xout = XOUT;
        pg8::GridOrder S_; S_.init(H, DM, WOUT, DM, TU, DM, G, cu); pg8::EpiOut E{xin, xout}; pg8::gemm_phase(lds, pg8::Gemm{DM, DM, DM}, S_, E);
      }
    }
    if (ap0->coop && ph + 1 < ph_hi) { if (ap0->coop == 2) grid_sync(); else xcd_barrier(xbar); }
#ifdef DBG
    {
      CArgsP ap = ap0; unsigned* DB = (unsigned*)(ap->ws + WS_DBG);
      int tid = threadIdx.x; const int lane = tid & 63, wid = tid >> 6; const int G = gridDim.x, cu = blockIdx.x;
      if (ph + 1 >= ph_hi) grid_sync();
      if (ph == 0) { if (cu == 0 && tid < 16) DB[tid] = 0u; }
      if (ph == 2) {
        for (int s = cu * 512 + tid; s < 32768; s += G * 512) {
          const unsigned hsh = dbg_hash(s * 2654435761u + 17u); const int t = hsh % TU, n = (hsh >> 14) % (NG1 - 96);
          float ref = 0.f; for (int k = 0; k < DM; ++k) ref += bf2f(H[(size_t)t * DM + k]) * bf2f(WIN[(size_t)n * DM + k]);
          const float got = n < 3072 ? bf2f(QB[(size_t)t * PQ + n]) : bf2f(KVB[(size_t)t * PKV + n - 3072]);
          dbg_max(DB + 0, fabsf(got - ref) / (fabsf(ref) + 0.05f));
        }
        for (int s = cu * 512 + tid; s < 8192; s += G * 512) {
          const unsigned hsh = dbg_hash(s * 2654435761u + 99u); const int t = hsh % 1024, n = (hsh >> 14) % 1024;
          float ref = 0.f; for (int k = 0; k < DM; ++k) ref += bf2f(MN[(size_t)t * DM + k]) * bf2f(WMEM[(size_t)n * DM + k]);
          dbg_max(DB + 3, fabsf(bf2f(MKV[(size_t)t * PMKV + n]) - ref) / (fabsf(ref) + 0.05f));
        }
      }
      if (ph == 4) {
        for (int s = cu * 512 + tid; s < 32768; s += G * 512) {
          const unsigned hsh = dbg_hash(s * 2654435761u + 5u); const int t = hsh % TU, n = (hsh >> 14) % 1152;
          float ref = 0.f; for (int k = 0; k < 384; ++k) ref += bf2f(KVB[(size_t)t * PKV + KC_CQ + k]) * bf2f(WMLA[(size_t)n * 384 + k]);
          dbg_max(DB + 4, fabsf(bf2f(MLA[(size_t)t * PMLA + n]) - ref) / (fabsf(ref) + 0.05f));
        }
      }
      if (ph == 6) {
        const int S = 4096, nqb = 16, per = 64, nB = per * 4, nA = per * 8; LAS float* sc = (LAS float*)lds;
        if (wid == 0) for (int it = cu; it < nB + nA; it += G) {
          const int rq = (it * 97 + 13) & 255; float e;
          if (it < nB) { const int j = it, blk = j % nqb, hh = (j / nqb) % 4, b = j / (nqb * 4); const size_t r0 = (size_t)b * S;
            e = dbg_attn_row<96, 128>(sc, MLA + r0 * PMLA + hh * 96, PMLA, BK + r0 * PBK + hh * 96, PBK, MLA + r0 * PMLA + 384 + hh * 192 + 64, PMLA, QB + r0 * PQ + QC_OB + hh * 128, PQ,
                                      blk * 256 + rq, S, 1 << 28, 0.f, -1e30f, 0.f, lane);
            if (lane == 0) dbg_max(DB + 2, e);
          } else { const int j = it - nB, blk = j % nqb, mh = (j / nqb) % 8, b = j / (nqb * 8), mm = mh >> 2, hh = mh & 3; const size_t r0 = (size_t)b * S;
            const float slope = exp2f(-2.0f * (hh + 1)) * LOG2E;
            e = dbg_attn_row<64, 128>(sc, QB + r0 * PQ + QC_AQ + mm * 256 + hh * 64, PQ, KVB + r0 * PKV + KC_AK + mm * 256 + hh * 64, PKV, KVB + r0 * PKV + KC_AV + hh * 128, PKV,
                                      QB + r0 * PQ + QC_OA + mm * 512 + hh * 128, PQ, blk * 256 + rq, S, 1 << 28, slope, -1e30f, 0.f, lane);
            if (lane == 0) dbg_max(DB + 1, e);
          }
        }
      }
      if (ph == 7) {
        const float* bg = ap->in[25];
        for (int s = cu * 512 + tid; s < 32768; s += G * 512) {
          const unsigned hsh = dbg_hash(s * 2654435761u + 7u); const int t = hsh % TU, n = (hsh >> 14) % NGT;
          float ref = 0.f; for (int k = 0; k < DM; ++k) ref += bf2f(H[(size_t)t * DM + k]) * bf2f(WIN[(size_t)(NG1 + NZ + n) * DM + k]);
          ref = 1.f / (1.f + expf(-(ref + bg[n])));
          dbg_max(DB + 8, fabsf(bf2f(GATE[(size_t)t * PGATE + n]) - ref) / (fabsf(ref) + 0.05f));
        }
      }
      if (ph == 9) {
        for (int s = cu * 512 + tid; s < 32768; s += G * 512) {
          const unsigned hsh = dbg_hash(s * 2654435761u + 9u); const int t = hsh % TU, c = (hsh >> 14) % DM;
          float ref = 0.f;
          for (int br = 0; br < 5; ++br) { const int ocol = br == 0 ? QC_OA : br == 1 ? QC_OB : br == 2 ? QC_CQ : br == 3 ? QC_DQ : QC_MQ;
            float tt = 0.f; for (int k = 0; k < 512; ++k) tt += bf2f(QB[(size_t)t * PQ + ocol + k]) * bf2f(WBR[(size_t)(br * 1024 + c) * 512 + k]);
            ref += bf2f(GATE[(size_t)t * PGATE + br * 1024 + c]) * tt; }
          dbg_max(DB + 9, fabsf(bf2f(H[(size_t)t * DM + c]) - ref) / (fabsf(ref) + 0.05f));
        }
      }
      if (ph == 10) {
        for (int s = cu * 512 + tid; s < 32768; s += G * 512) {
          const unsigned hsh = dbg_hash(s * 2654435761u + 11u); const int t = hsh % TU, c = (hsh >> 14) % DM;
          float ref = 0.f; for (int k = 0; k < DM; ++k) ref += bf2f(H[(size_t)t * DM + k]) * bf2f(WOUT[(size_t)c * DM + k]);
          ref += ap->in[0][(size_t)t * DM + c];
          dbg_max(DB + 10, fabsf(ap->out[(size_t)t * DM + c] - ref) / (fabsf(ref) + 0.05f));
        }
      }
      if (ph == 2 || ph == 4 || ph == 6 || ph == 0 || ph == 7 || ph == 9) grid_sync();
      if (ph + 1 == ph_hi) {
        grid_sync();
        const float e1 = __uint_as_float(DB[DBG_SEL1]), e2 = __uint_as_float(DB[DBG_SEL2]);
        const float k1 = fminf(fmaxf(log10f(e1 + 1e-30f) + 5.f, 0.f), 7.f), k2 = fminf(fmaxf(log10f(e2 + 1e-30f) + 5.f, 0.f), 7.f);
        for (size_t i = (size_t)cu * 512 + tid; i < (size_t)49152 * DM; i += (size_t)G * 512) {
          const float xv = i < (size_t)TU * DM ? ap->in[0][i] : ap->in[1][i - (size_t)TU * DM];
          ap->out[i] = (i == 0) ? 100.f * k2 : xv * (1.f + k1);
        }
      }
    }
#endif
  }
}

extern "C" void kernel_launch(void* const* d_in, const int* in_sizes, int n_in, void* d_out, int out_size, void* d_ws, size_t ws_size, hipStream_t stream) {
  static int grid = 0;
  if (!grid) {
    if (n_in != 28 || ws_size < WS_END) { fprintf(stderr, "kernel_launch: unexpected n_in %d or ws_size %zu (< %zu)\n", n_in, ws_size, (size_t)WS_END); grid = -1; }
    else {
      int dev = 0, cus = 0, per_cu = 0;
      hipGetDevice(&dev); hipDeviceGetAttribute(&cus, hipDeviceAttributeMultiprocessorCount, dev);
      hipFuncSetAttribute((const void*)mega, hipFuncAttributeMaxDynamicSharedMemorySize, LDS_BYTES);
      hipOccupancyMaxActiveBlocksPerMultiprocessor(&per_cu, mega, 512, LDS_BYTES);
      grid = cus * (per_cu > 0 ? 1 : 0);
      if (grid > 256) grid = 256;
      if (grid <= 0) { fprintf(stderr, "kernel_launch: occupancy query says %d blocks/CU\n", per_cu); grid = -1; }
    }
  }
  if (grid <= 0) return;
  Args a{};
  for (int i = 0; i < 28; ++i) a.in[i] = (const float*)d_in[i];
  a.out = (float*)d_out; a.ws = (unsigned char*)d_ws; a.ph_lo = 0; a.ph_hi = DBG_PH_HI; a.coop = 1; a.pad = 31 | (DBG_BMASK << 8);
  if (hipMemsetAsync(d_ws, 0, 65536, stream) != hipSuccess) { fprintf(stderr, "kernel_launch: memset of barrier words failed\n"); return; }
  void* params[] = {&a};
  hipError_t e = hipLaunchCooperativeKernel((const void*)mega, dim3(grid), dim3(512), params, LDS_BYTES, stream);
  if (e != hipSuccess) fprintf(stderr, "cooperative launch failed: %s (grid %d)\n", hipGetErrorString(e), grid);
}
```

```cpp
#include <hip/hip_runtime.h>
#include <hip/hip_cooperative_groups.h>
#include <cstdio>
#include <cstdint>
namespace cg = cooperative_groups;

#define LAS __attribute__((address_space(3)))
#define DI __device__ __forceinline__
typedef unsigned short bf16_t;
typedef short bf16x8 __attribute__((ext_vector_type(8)));
typedef short s16x4 __attribute__((ext_vector_type(4)));
typedef float f32x4 __attribute__((ext_vector_type(4)));
typedef float f32x16 __attribute__((ext_vector_type(16)));
typedef unsigned u32x4 __attribute__((ext_vector_type(4)));
typedef unsigned u32x2 __attribute__((ext_vector_type(2)));

constexpr int DM = 1024, NIN = 15520, TU = 16384  , NUNIT = 3, DEPTH = 2;
constexpr int PQ = 4608, PKV = 4864, PMLA = 1280, PBK = 384, PGATE = 5120, PMKV = 1024;
constexpr int NG1 = 7936, NZ = 2560, NGT = 5120, NWIN = NG1 + NZ + NGT;
constexpr float LOG2E = 1.4426950408889634f, EPS = 1e-6f;
constexpr int QC_AQ = 0, QC_CQ = 512, QC_DQ = 1024, QC_MQ = 2560, QC_OA = 3072, QC_OB = 4096;
constexpr int KC_AK = 0, KC_AV = 512, KC_CK = 1024, KC_CV = 1152, KC_DK = 1280, KC_DV = 2816, KC_CQ = 4352, KC_CKV = 4608, KC_KR = 4736;
constexpr size_t MiB = 1u << 20;
constexpr size_t WS_ROPE = 1 * MiB, WS_WIN = 2 * MiB, WS_WMLA = 33 * MiB, WS_WMEM = 34 * MiB, WS_WBR = 38 * MiB, WS_WOUT = 43 * MiB,
                 WS_MN = 45 * MiB, WS_MKV = 47 * MiB, WS_LSE = 51 * MiB, WS_H = 54 * MiB, WS_QB = 86 * MiB, WS_KVB = 230 * MiB,
                 WS_MLA = 382 * MiB, WS_BK = 422 * MiB, WS_GATE = 230 * MiB, WS_END = 434 * MiB;
constexpr int LDS_BYTES = 131072 + 256;

#define DBG_SEL1 9
#define DBG_SEL2 10
#ifdef DBG
#define DBG_PH_HI 11
#else
#define DBG_PH_HI 62
#endif
#ifndef DBG_BMASK
#define DBG_BMASK 31
#endif
struct Args { const float* in[28]; float* out; unsigned char* ws; int ph_lo, ph_hi, coop, pad; };

DI float bf2f(unsigned short b) { return __uint_as_float(((unsigned)b) << 16); }
typedef __bf16 bf16x2_t __attribute__((ext_vector_type(2)));
typedef float f32x2_t __attribute__((ext_vector_type(2)));
DI unsigned cvt_pk(float lo, float hi) { const f32x2_t v = {lo, hi}; const bf16x2_t b = __builtin_convertvector(v, bf16x2_t); return __builtin_bit_cast(unsigned, b); }
DI void unpack8(const u32x4 w, float* v) {
#pragma unroll
  for (int i = 0; i < 4; ++i) { v[2 * i] = __uint_as_float(w[i] << 16); v[2 * i + 1] = __uint_as_float(w[i] & 0xffff0000u); }
}
DI u32x4 pack8(const float* v) { u32x4 w; w.x = cvt_pk(v[0], v[1]); w.y = cvt_pk(v[2], v[3]); w.z = cvt_pk(v[4], v[5]); w.w = cvt_pk(v[6], v[7]); return w; }
DI float fexp2(float x) { return __builtin_amdgcn_exp2f(x); }
DI float sigmoidf_(float x) { return __builtin_amdgcn_rcpf(1.0f + fexp2(-x * LOG2E)); }

namespace pg8 {
constexpr int BM = 256, BK = 64, HALF = 128, HTB = HALF * BK * 2, NXCD = 8, WGM = 8;
__host__ __device__ __forceinline__ int lds_byte(int r, int c) { const int st = (r >> 4) * 2 + (c >> 5), rr = r & 15, cc = c & 31, ob = rr * 64 + cc * 2; return st * 1024 + (ob ^ (((ob >> 9) & 1) << 5)); }
__host__ __device__ __forceinline__ void stage_rc(int b, int& R, int& C) { const int st = b / 1024, sb = b % 1024, swz = sb ^ (((sb >> 9) & 1) << 5); R = (st >> 1) * 16 + swz / 64; C = (st & 1) * 32 + (swz % 64) / 2; }
__host__ __device__ __forceinline__ int perm32(int rho) { const int n = rho >> 4, i = rho & 15; return 8 * (i >> 2) + 4 * n + (i & 3); }

struct Unit { const char* a; const char* b; int pm, pn, aux; };
struct Gemm { int lda, ldb, K; };

struct GridOrder {
  const char* A; const char* B; int lda, ldb, nM, nN, nwg, G, c;
  DI void init(const void* A_, int lda_, const void* B_, int ldb_, int M, int N, int G_, int c_) { A = (const char*)A_; B = (const char*)B_; lda = lda_; ldb = ldb_; nM = M / BM; nN = N / BM; nwg = nM * nN; G = G_; c = c_; }
  DI bool next(int i, Unit& u) const {
    const long L = (long)i * G + c; if (L >= nwg) return false;
    int wgid = (int)L; { const int q = nwg / NXCD, r = nwg % NXCD, xcd = wgid % NXCD, off = wgid / NXCD; wgid = (xcd < r ? xcd * (q + 1) : r * (q + 1) + (xcd - r) * q) + off; }
    const int nig = WGM * nN, gid = wgid / nig, fm = gid * WGM, gsz = (nM - fm) < WGM ? (nM - fm) : WGM;
    u.pm = fm + ((wgid % nig) % gsz); u.pn = (wgid % nig) / gsz; u.aux = 0;
    u.a = A + (size_t)u.pm * BM * lda * 2; u.b = B + (size_t)u.pn * BM * ldb * 2; return true;
  }
};
struct MergeOrder {
  const char* QBp; const char* WBR; int ntiles, G, c;
  DI bool next(int i, Unit& u) const {
    const int k = i / 5, br = i - k * 5; const int tile = c + k * G; if (tile >= ntiles) return false;
    u.pm = tile >> 2; u.pn = tile & 3; u.aux = br;
    const int ocol = br == 0 ? QC_OA : br == 1 ? QC_OB : br == 2 ? QC_CQ : br == 3 ? QC_DQ : QC_MQ;
    u.a = QBp + ((size_t)u.pm * BM * PQ + ocol) * 2; u.b = WBR + ((size_t)(br * 1024 + u.pn * BM) * 512) * 2; return true;
  }
};

template <class Epi, class Sched>
DI void gemm_phase(LAS unsigned char* lds, const Gemm g, const Sched& S, const Epi& E) {
  int tid = threadIdx.x; asm volatile("" : "+v"(tid));
  const int wid = __builtin_amdgcn_readfirstlane(tid >> 6), lane = tid & 63, wr = wid >> 2, wc = wid & 3, fr = lane & 15, fq = lane >> 4;
  const int K = g.K, nt = K / BK;
  unsigned voffA[2], voffB[2];
#pragma unroll
  for (int i = 0; i < 2; ++i) { int R, C; stage_rc(tid * 16 + i * 8192, R, C); const int Rb = (R & ~31) + perm32(R & 31);
    voffA[i] = (unsigned)(R * g.lda + C) * 2u; voffB[i] = (unsigned)(Rb * g.ldb + C) * 2u; }
  const size_t kstep = (size_t)(BK * 2);
  const size_t hstepA = (size_t)HALF * g.lda * 2, hstepB = (size_t)HALF * g.ldb * 2;
  const unsigned ldsw = (unsigned)wid * 1024u;
  const int aoff = lds_byte(wr * 64 + fr, fq * 8), boff = lds_byte(wc * 32 + fr, fq * 8);
#define PG8_SA(b, h) (((b) * 2 + (h)) * HTB)
#define PG8_SB(b, h) ((4 + (b) * 2 + (h)) * HTB)
#define PG8_STAGE(bufoff, gbase, voff) do { _Pragma("unroll") for (int _i = 0; _i < 2; ++_i) \
    __builtin_amdgcn_global_load_lds((const unsigned*)((const char*)(gbase) + (voff)[_i]), (LAS unsigned*)(lds + (bufoff) + ldsw + _i * 8192), 16, 0, 0); } while (0)
#define PG8_LDA(dst, b, h) do { _Pragma("unroll") for (int m = 0; m < 4; ++m) _Pragma("unroll") for (int k = 0; k < 2; ++k) dst[m][k] = *(const LAS bf16x8*)(lds + PG8_SA(b, h) + aoff + m * 2048 + k * 1024); } while (0)
#define PG8_LDB(dst, b, h) do { _Pragma("unroll") for (int n = 0; n < 2; ++n) _Pragma("unroll") for (int k = 0; k < 2; ++k) dst[n][k] = *(const LAS bf16x8*)(lds + PG8_SB(b, h) + boff + n * 2048 + k * 1024); } while (0)
#define PG8_MMA(ai, bj, At, Bt) do { __builtin_amdgcn_s_setprio(1); _Pragma("unroll") for (int m = 0; m < 4; ++m) _Pragma("unroll") for (int n = 0; n < 2; ++n) _Pragma("unroll") for (int k = 0; k < 2; ++k) \
    acc[ai][bj][m][n] = __builtin_amdgcn_mfma_f32_16x16x32_bf16(Bt[n][k], At[m][k], acc[ai][bj][m][n], 0, 0, 0); __builtin_amdgcn_s_setprio(0); } while (0)
#define PG8_WAIT_V(n) asm volatile("s_waitcnt vmcnt(" #n ")" ::: "memory")
#define PG8_WAIT_L(n) asm volatile("s_waitcnt lgkmcnt(" #n ")" ::: "memory")
#define PG8_BAR __builtin_amdgcn_s_barrier()
#define PG8_SCHED __builtin_amdgcn_sched_barrier(0)
  Unit cur, nxt; int ui = 0;
  if (!S.next(0, cur)) return;
  f32x4 acc[2][2][4][2];
#pragma unroll
  for (int a = 0; a < 2; ++a)
#pragma unroll
    for (int b = 0; b < 2; ++b)
#pragma unroll
      for (int m = 0; m < 4; ++m)
#pragma unroll
        for (int n = 0; n < 2; ++n) acc[a][b][m][n] = (f32x4){0.f, 0.f, 0.f, 0.f};
  bf16x8 At[4][2], B0[2][2], B1[2][2];
  const char* cA = cur.a; const char* cB = cur.b;
  PG8_STAGE(PG8_SB(0, 0), cB, voffB); PG8_STAGE(PG8_SB(0, 1), cB + hstepB, voffB); PG8_STAGE(PG8_SA(0, 0), cA, voffA); PG8_STAGE(PG8_SA(0, 1), cA + hstepA, voffA);
  if (wr == 1) PG8_BAR;
  PG8_WAIT_V(2); PG8_BAR;
  PG8_STAGE(PG8_SB(1, 0), cB + kstep, voffB); PG8_STAGE(PG8_SA(1, 0), cA + kstep, voffA); PG8_STAGE(PG8_SB(1, 1), cB + hstepB + kstep, voffB);
  PG8_WAIT_V(6); PG8_BAR;
  for (;;) {
    const bool has_next = S.next(ui + 1, nxt);
    const char* nA = has_next ? nxt.a : cA; const char* nB = has_next ? nxt.b : cB;
    for (int t = 0; t < nt; t += 2) {
      const bool last = (t == nt - 2);
      const char* a1 = cA + (size_t)(t + 1) * kstep;
      const char* a2 = last ? nA : cA + (size_t)(t + 2) * kstep; const char* b2 = last ? nB : cB + (size_t)(t + 2) * kstep;
      const char* a3 = a2 + kstep; const char* b3 = b2 + kstep;
      PG8_LDB(B0, 0, 0); PG8_LDB(B1, 0, 1); PG8_SCHED; PG8_LDA(At, 0, 0); PG8_STAGE(PG8_SA(1, 1), a1 + hstepA, voffA);
      PG8_WAIT_V(8); PG8_WAIT_L(0); PG8_BAR; PG8_MMA(0, 0, At, B0); PG8_MMA(0, 1, At, B1); PG8_BAR; PG8_SCHED;
      PG8_LDA(At, 0, 1); PG8_STAGE(PG8_SB(0, 0), b2, voffB); PG8_STAGE(PG8_SB(0, 1), b2 + hstepB, voffB); PG8_STAGE(PG8_SA(0, 0), a2, voffA);
      PG8_WAIT_V(8); PG8_WAIT_L(0); PG8_BAR; PG8_MMA(1, 0, At, B0); PG8_MMA(1, 1, At, B1); PG8_BAR; PG8_SCHED;
      PG8_LDB(B0, 1, 0); PG8_LDB(B1, 1, 1); PG8_SCHED; PG8_LDA(At, 1, 0); PG8_STAGE(PG8_SA(0, 1), a2 + hstepA, voffA);
      PG8_WAIT_V(8); PG8_WAIT_L(0); PG8_BAR; PG8_MMA(0, 0, At, B0); PG8_MMA(0, 1, At, B1); PG8_BAR; PG8_SCHED;
      PG8_LDA(At, 1, 1); PG8_STAGE(PG8_SB(1, 0), b3, voffB); PG8_STAGE(PG8_SB(1, 1), b3 + hstepB, voffB); PG8_STAGE(PG8_SA(1, 0), a3, voffA);
      PG8_WAIT_V(8); PG8_WAIT_L(0); PG8_BAR; PG8_MMA(1, 0, At, B0); PG8_MMA(1, 1, At, B1); PG8_BAR; PG8_SCHED;
    }
    if (wr == 0) PG8_BAR;
    E(acc, cur, wr, wc, fr, fq);
    if (!has_next) break;
    bool carry = false;
    if constexpr (Epi::KEEPS) carry = E.keep(cur);
    if (!carry) {
#pragma unroll
    for (int a = 0; a < 2; ++a)
#pragma unroll
      for (int b = 0; b < 2; ++b)
#pragma unroll
        for (int m = 0; m < 4; ++m)
#pragma unroll
          for (int n = 0; n < 2; ++n) acc[a][b][m][n] = (f32x4){0.f, 0.f, 0.f, 0.f};
    }
    cur = nxt; cA = nA; cB = nB; ++ui;
    if (wr == 1) PG8_BAR;
  }
  PG8_WAIT_V(0);
  PG8_BAR;
#undef PG8_SA
#undef PG8_SB
#undef PG8_STAGE
#undef PG8_LDA
#undef PG8_LDB
#undef PG8_MMA
#undef PG8_WAIT_V
#undef PG8_WAIT_L
#undef PG8_BAR
#undef PG8_SCHED
}

template <class F> DI void epi_each(const f32x4 (&acc)[2][2][4][2], int wr, int wc, int fr, int fq, F f) {
  asm volatile("" : "+v"(fr), "+v"(fq));
#pragma unroll
  for (int ai = 0; ai < 2; ++ai)
#pragma unroll
    for (int m = 0; m < 4; ++m) { const int row = ai * HALF + wr * 64 + m * 16 + fr;
#pragma unroll
      for (int bj = 0; bj < 2; ++bj) { const int col = bj * HALF + wc * 32 + 8 * fq; f(row, col, acc[ai][bj][m][0], acc[ai][bj][m][1]); } }
}
template <int NB, class A, class L, class U>
DI void epi_batched(A& acc, int wr, int wc, int fr, int fq, L load, U use) {
  asm volatile("" : "+v"(fr), "+v"(fq));
#pragma unroll
  for (int b = 0; b < 16; b += NB) {
#pragma unroll
    for (int k = 0; k < NB; ++k) { const int idx = b + k, ai = idx >> 3, m = (idx >> 1) & 3, bj = idx & 1; load(k, ai * HALF + wr * 64 + m * 16 + fr, bj * HALF + wc * 32 + 8 * fq); }
    __builtin_amdgcn_sched_barrier(0);
#pragma unroll
    for (int k = 0; k < NB; ++k) { const int idx = b + k, ai = idx >> 3, m = (idx >> 1) & 3, bj = idx & 1; use(k, ai * HALF + wr * 64 + m * 16 + fr, bj * HALF + wc * 32 + 8 * fq, acc[ai][bj][m][0], acc[ai][bj][m][1]); }
    __builtin_amdgcn_sched_barrier(0);
  }
}
DI u32x4 pk8(const f32x4 a, const f32x4 b) { u32x4 w; w.x = cvt_pk(a[0], a[1]); w.y = cvt_pk(a[2], a[3]); w.z = cvt_pk(b[0], b[1]); w.w = cvt_pk(b[2], b[3]); return w; }

__host__ __device__ __forceinline__ bool g1a_perm_tile(int pn) { return pn < 10 || pn == 12 || pn == 13 || (pn >= 16 && pn <= 22); }
struct EpiG1a {
  static constexpr bool KEEPS = false;
  bf16_t* QBp; bf16_t* KVBp; const float* a_qn; const float* c_qn; const float* d_qn; const float* a_kn; const float* c_kn; const float* d_kn;
  DI void operator()(const f32x4 (&acc)[2][2][4][2], const Unit& u, int wr, int wc, int fr, int fq) const {
    bf16_t* base; int ld; const int pn = u.pn;
    if (pn < 12) { base = QBp + pn * BM; ld = PQ; } else { base = KVBp + (pn - 12) * BM; ld = PKV; }
    base += (size_t)u.pm * BM * ld;
    if (!g1a_perm_tile(pn)) {
      epi_each(acc, wr, wc, fr, fq, [&](int row, int col, const f32x4 v0, const f32x4 v1) { *(u32x4*)(base + (size_t)row * ld + col) = pk8(v0, v1); });
      return;
    }
    asm volatile("" : "+v"(fr), "+v"(fq));
    const float* gp; float post = 1.0f; bool norm = true;
    if (pn < 2) { gp = a_qn; post = 0.125f * LOG2E; } else if (pn < 4) { gp = c_qn; post = 0.125f * LOG2E; } else if (pn < 10) { gp = d_qn; post = 0.125f * LOG2E; }
    else if (pn < 14) gp = a_kn; else if (pn == 16) { gp = c_kn; norm = wc < 2; } else gp = d_kn;
    const f32x4 g00 = *(const f32x4*)(gp + 8 * fq), g01 = *(const f32x4*)(gp + 8 * fq + 4), g10 = *(const f32x4*)(gp + 32 + 8 * fq), g11 = *(const f32x4*)(gp + 32 + 8 * fq + 4);
#pragma unroll
    for (int ai = 0; ai < 2; ++ai)
#pragma unroll
      for (int m = 0; m < 4; ++m) {
        const int row = ai * HALF + wr * 64 + m * 16 + fr;
        f32x4 v00 = acc[ai][0][m][0], v01 = acc[ai][0][m][1], v10 = acc[ai][1][m][0], v11 = acc[ai][1][m][1];
        float ss = 0.f;
#pragma unroll
        for (int j = 0; j < 4; ++j) ss += v00[j] * v00[j] + v01[j] * v01[j] + v10[j] * v10[j] + v11[j] * v11[j];
        ss += __shfl_xor(ss, 16); ss += __shfl_xor(ss, 32);
        if (norm) { const float r = rsqrtf(ss * (1.0f / 64.0f) + EPS) * post; v00 = v00 * r * g00; v01 = v01 * r * g01; v10 = v10 * r * g10; v11 = v11 * r * g11; }
        bf16_t* p = base + (size_t)row * ld + wc * 64 + 8 * fq;
        *(u32x4*)p = pk8(v00, v01); *(u32x4*)(p + 32) = pk8(v10, v11);
      }
  }
};
struct EpiPlain {
  static constexpr bool KEEPS = false;
  bf16_t* C; int ldc;
  DI void operator()(const f32x4 (&acc)[2][2][4][2], const Unit& u, int wr, int wc, int fr, int fq) const {
    bf16_t* base = C + (size_t)u.pm * BM * ldc + u.pn * BM;
    epi_each(acc, wr, wc, fr, fq, [&](int row, int col, const f32x4 v0, const f32x4 v1) { *(u32x4*)(base + (size_t)row * ldc + col) = pk8(v0, v1); });
  }
};
struct EpiGate {
  static constexpr bool KEEPS = false;
  bf16_t* C; const float* bias;
  DI void operator()(const f32x4 (&acc)[2][2][4][2], const Unit& u, int wr, int wc, int fr, int fq) const {
    bf16_t* base = C + (size_t)u.pm * BM * PGATE + u.pn * BM; const float* bb = bias + u.pn * BM + wc * 32 + 8 * fq;
    f32x4 bv[2][2];
#pragma unroll
    for (int bj = 0; bj < 2; ++bj) { bv[bj][0] = *(const f32x4*)(bb + bj * HALF); bv[bj][1] = *(const f32x4*)(bb + bj * HALF + 4); }
    epi_batched<8>(acc, wr, wc, fr, fq, [&](int, int, int) {}, [&](int k, int row, int col, f32x4 v0, f32x4 v1) {
      const f32x4 b0 = bv[k & 1][0], b1 = bv[k & 1][1];
#pragma unroll
      for (int j = 0; j < 4; ++j) { v0[j] = sigmoidf_(v0[j] + b0[j]); v1[j] = sigmoidf_(v1[j] + b1[j]); }
      *(u32x4*)(base + (size_t)row * PGATE + col) = pk8(v0, v1); });
  }
};
struct EpiZ {
  static constexpr bool KEEPS = false;
  bf16_t* QBp;
  DI void operator()(const f32x4 (&acc)[2][2][4][2], const Unit& u, int wr, int wc, int fr, int fq) const {
    const int br = u.pn >> 1; const int ocol = (br == 0 ? QC_OA : br == 1 ? QC_OB : br == 2 ? QC_CQ : br == 3 ? QC_DQ : QC_MQ) + (u.pn & 1) * BM;
    bf16_t* base = QBp + (size_t)u.pm * BM * PQ + ocol;
    u32x4 ob[8];
    epi_batched<8>(acc, wr, wc, fr, fq, [&](int k, int row, int col) { ob[k] = *(const u32x4*)(base + (size_t)row * PQ + col); },
      [&](int k, int row, int col, f32x4 v0, f32x4 v1) {
        float o[8]; unpack8(ob[k], o);
#pragma unroll
        for (int j = 0; j < 4; ++j) { v0[j] = o[j] * v0[j] * sigmoidf_(v0[j]); v1[j] = o[4 + j] * v1[j] * sigmoidf_(v1[j]); }
        *(u32x4*)(base + (size_t)row * PQ + col) = pk8(v0, v1); });
  }
};
struct EpiMerge {
  static constexpr bool KEEPS = true;
  bf16_t* ACC; const bf16_t* GATEp; int bmask;
  DI bool keep(const Unit& u) const { return u.aux < 4; }
  DI void operator()(f32x4 (&acc)[2][2][4][2], const Unit& u, int wr, int wc, int fr, int fq) const {
    const int br = u.aux;
    bf16_t* base = ACC + (size_t)u.pm * BM * DM + u.pn * BM; const bf16_t* gb = GATEp + (size_t)u.pm * BM * PGATE + br * 1024 + u.pn * BM;
    u32x4 ga[4], gn[4];
    if (br < 4) {
      epi_batched<4>(acc, wr, wc, fr, fq, [&](int k, int row, int col) { ga[k] = *(const u32x4*)(gb + (size_t)row * PGATE + col); gn[k] = *(const u32x4*)(gb + 1024 + (size_t)row * PGATE + col); },
        [&](int k, int, int, f32x4& v0, f32x4& v1) {
          float g0[8], g1[8]; unpack8(ga[k], g0); unpack8(gn[k], g1);
#pragma unroll
          for (int j = 0; j < 4; ++j) { v0[j] *= g0[j] * __builtin_amdgcn_rcpf(fmaxf(g1[j], 1e-20f)); v1[j] *= g0[4 + j] * __builtin_amdgcn_rcpf(fmaxf(g1[4 + j], 1e-20f)); } });
    } else {
      epi_batched<4>(acc, wr, wc, fr, fq, [&](int k, int row, int col) { ga[k] = *(const u32x4*)(gb + (size_t)row * PGATE + col); },
        [&](int k, int row, int col, f32x4& a0, f32x4& a1) {
          float g0[8]; unpack8(ga[k], g0); f32x4 v0 = a0, v1 = a1;
#pragma unroll
          for (int j = 0; j < 4; ++j) { v0[j] *= g0[j]; v1[j] *= g0[4 + j]; }
          *(u32x4*)(base + (size_t)row * DM + col) = pk8(v0, v1); });
    }
  }
};
struct EpiOut {
  static constexpr bool KEEPS = false;
  const float* X; float* Y;
  DI void operator()(const f32x4 (&acc)[2][2][4][2], const Unit& u, int wr, int wc, int fr, int fq) const {
    const size_t off = (size_t)u.pm * BM * DM + u.pn * BM;
    f32x4 xa[4], xb[4];
    epi_batched<4>(acc, wr, wc, fr, fq, [&](int k, int row, int col) { const size_t o = off + (size_t)row * DM + col; xa[k] = *(const f32x4*)(X + o); xb[k] = *(const f32x4*)(X + o + 4); },
      [&](int k, int row, int col, const f32x4 v0, const f32x4 v1) { const size_t o = off + (size_t)row * DM + col; *(f32x4*)(Y + o) = xa[k] + v0; *(f32x4*)(Y + o + 4) = xb[k] + v1; });
  }
};
}

DI void grid_sync() {
  __builtin_amdgcn_fence(__ATOMIC_RELEASE, "agent");
  asm volatile("s_waitcnt vmcnt(0)" ::: "memory");
  cg::this_grid().sync();
  __builtin_amdgcn_fence(__ATOMIC_ACQUIRE, "agent");
  asm volatile("s_waitcnt vmcnt(0)" ::: "memory");
}

#define XB_TMO      128
#define XB_XCNT(j)  (256  + 64 * (j))
#define XB_XSUB(j)  (1280 + 64 * (j))
#define XB_XGEN(j)  (2304 + 64 * (j))
#define XB_TOP      3328
#define XB_TOPGEN   3392
#define XCD_BAR_WORDS 3456
#define XB_SPIN_CAP (1u << 22)
DI unsigned xb_ld(unsigned* p)              { return __hip_atomic_load(p, __ATOMIC_RELAXED, __HIP_MEMORY_SCOPE_AGENT); }
DI unsigned xb_add(unsigned* p, unsigned v) { return __hip_atomic_fetch_add(p, v, __ATOMIC_RELAXED, __HIP_MEMORY_SCOPE_AGENT); }
DI unsigned xb_xcc_id() { return (unsigned)__builtin_amdgcn_s_getreg((3 << 11) | 20) & 0xFu; }
#define XB_SPIN(cond, bar) do { unsigned _sp = 0; while (cond) { __builtin_amdgcn_s_sleep(1); \
    if ((++_sp & 255u) == 0u) { if (xb_ld(&(bar)[XB_TMO])) break; if (_sp > XB_SPIN_CAP) { atomicAdd(&(bar)[XB_TMO], 1u); break; } } } } while (0)
struct XcdBarrier { unsigned* bar; unsigned x; volatile LAS unsigned* st; };
DI XcdBarrier xcd_barrier_post(unsigned* bar, volatile LAS unsigned* st) {
  XcdBarrier b; b.bar = bar; b.x = xb_xcc_id(); b.st = st;
  if (threadIdx.x == 0) (void)xb_add(&bar[XB_XCNT(b.x)], 1u);
  return b;
}
DI void xcd_barrier_complete(unsigned* bar, unsigned x, unsigned& nloc, unsigned& nx) {
  const unsigned G = gridDim.x * gridDim.y * gridDim.z;
  unsigned sum, cnt, mine, sp = 0u;
  for (;;) {
    sum = 0u; cnt = 0u; mine = 0u;
#pragma unroll
    for (unsigned j = 0; j < 16; ++j) { const unsigned c = xb_ld(&bar[XB_XCNT(j)]); sum += c; cnt += (c > 0u) ? 1u : 0u; mine = (j == x) ? c : mine; }
    if (sum == G) break;
    __builtin_amdgcn_s_sleep(1);
    if ((++sp & 255u) == 0u) { if (xb_ld(&bar[XB_TMO])) break; if (sp > XB_SPIN_CAP) { atomicAdd(&bar[XB_TMO], 1u); break; } }
  }
  nloc = mine > 0u ? mine : 1u; nx = cnt > 0u ? cnt : 1u;
}
DI void xcd_barrier(const XcdBarrier& b) {
  asm volatile("s_waitcnt vmcnt(0)" ::: "memory");
  __syncthreads();
  if (threadIdx.x == 0) {
    unsigned* bar = b.bar;
    __builtin_amdgcn_s_waitcnt(0);
    unsigned nloc = b.st[0], nx = b.st[1];
    if (nloc == 0u) { xcd_barrier_complete(bar, b.x, nloc, nx); b.st[0] = nloc; b.st[1] = nx; }
    const unsigned old = xb_add(&bar[XB_XSUB(b.x)], 1u);
    const unsigned gen = old / nloc;
    if (old + 1u == (gen + 1u) * nloc) {
      __builtin_amdgcn_fence(__ATOMIC_RELEASE, "agent");
      asm volatile("s_waitcnt vmcnt(0)" ::: "memory");
      const unsigned og = xb_add(&bar[XB_TOP], 1u);
      const unsigned tg = og / nx;
      if (og + 1u == (tg + 1u) * nx) xb_add(&bar[XB_TOPGEN], 1u);
      else XB_SPIN(xb_ld(&bar[XB_TOPGEN]) == tg, bar);
      __builtin_amdgcn_fence(__ATOMIC_ACQUIRE, "agent");
      xb_add(&bar[XB_XGEN(b.x)], 1u);
      asm volatile("s_waitcnt vmcnt(0)" ::: "memory");
    } else {
      XB_SPIN(xb_ld(&bar[XB_XGEN(b.x)]) == gen, bar);
      __builtin_amdgcn_fence(__ATOMIC_ACQUIRE, "agent");
      asm volatile("s_waitcnt vmcnt(0)" ::: "memory");
    }
  }
  __syncthreads();
}
template <class F>
DI void tconv(LAS float* tile, bf16_t* dst, int ldd, int Nd, int K, F f, int cu, int ncu) {
  int tid = threadIdx.x; asm volatile("" : "+v"(tid)); const int ntk = K / 64, ntot = (Nd / 64) * ntk;
  for (int t = cu; t < ntot; t += ncu) {
    const int n0 = (t / ntk) * 64, k0 = (t % ntk) * 64;
#pragma unroll
    for (int i = 0; i < 8; ++i) { const int e = tid + i * 512, kk = e >> 6, nn = e & 63; tile[kk * 65 + nn] = f(k0 + kk, n0 + nn); }
    __syncthreads();
    { const int n = tid >> 3, kc = (tid & 7) * 8; float v[8];
#pragma unroll
      for (int j = 0; j < 8; ++j) v[j] = tile[(kc + j) * 65 + n];
      *(u32x4*)(dst + (size_t)(n0 + n) * ldd + k0 + kc) = pack8(v); }
    __syncthreads();
  }
}
DI int win_src(int n) {
  if (n < NG1 && pg8::g1a_perm_tile(n >> 8)) { const int ct = n & 255; n = (n & ~255) + ((ct >> 5) & 3) * 64 + (ct >> 7) * 32 + (ct & 31); }
  if (n < 3072) { if (n < 512) return n; if (n < 1024) return 1952 + (n - 512); if (n < 2560) return 2720 + (n - 1024); return 7328 + (n - 2560); }
  if (n < NG1) { const int c = n - 3072;
    if (c < 512) return 512 + c; if (c < 1024) return 1024 + (c - 512); if (c < 1152) return 2464 + (c - 1024); if (c < 1280) return 2592 + (c - 1152);
    if (c < 2816) return 4256 + (c - 1280); if (c < 4352) return 5792 + (c - 2816); if (c < 4608) return 1536 + (c - 4352); if (c < 4736) return 1792 + (c - 4608);
    if (c < 4768) return 1920 + (c - 4736); return -1; }
  return 7840 + (n - NG1);
}

DI u32x4 ldraw(const bf16_t* src, bool act) { u32x4 raw = (u32x4){0u, 0u, 0u, 0u}; if (act) raw = *(const u32x4*)src; return raw; }
template <int LPH>
DI void seg_norm(const bf16_t* src, bf16_t* dst, bool act, const float* gain, float post, float* vout, const u32x4* pre = nullptr, float inscale = 1.0f) {
  float v[8]; u32x4 raw; if (pre) raw = *pre; else raw = ldraw(src, act); unpack8(raw, v);
#pragma unroll
  for (int i = 0; i < 8; ++i) v[i] *= inscale;
  float ss = 0.f;
#pragma unroll
  for (int i = 0; i < 8; ++i) ss += v[i] * v[i];
#pragma unroll
  for (int o = 1; o < LPH; o <<= 1) ss += __shfl_xor(ss, o);
  const float r = rsqrtf(ss * (1.0f / (LPH * 8)) + EPS) * post;
#pragma unroll
  for (int i = 0; i < 8; ++i) v[i] = v[i] * r * (act ? gain[i] : 0.f);
  if (vout) {
#pragma unroll
    for (int i = 0; i < 8; ++i) vout[i] = v[i];
  } else if (act) *(u32x4*)dst = pack8(v);
}
DI void rope4(float* v, int lane4, const float* cs  , const float* sn  ) {
  const int jb = (lane4 & 1) * 8;
#pragma unroll
  for (int i = 0; i < 8; ++i) {
    const float partner = __shfl_xor(v[i], 2);
    const float c = cs[jb + i], s = sn[jb + i];
    v[i] = (lane4 < 2) ? (v[i] * c - partner * s) : (v[i] * c + partner * s);
  }
}


#define AT_SB __builtin_amdgcn_sched_barrier(0)
template <int NS, int KP>
DI void attn_qk(f32x16 (&st)[2], const bf16x8 (&qf)[NS], const LAS unsigned char* kbl  ) {
#pragma unroll
  for (int i = 0; i < 16; ++i) { st[0][i] = 0.f; st[1][i] = 0.f; }
  bf16x8 a0 = *(const LAS bf16x8*)(kbl), a1 = *(const LAS bf16x8*)(kbl + 32 * KP);
#pragma unroll
  for (int s = 0; s < NS; ++s) {
    bf16x8 n0 = a0, n1 = a1;
    if (s + 1 < NS) { n0 = *(const LAS bf16x8*)(kbl + 32 * (s + 1)); n1 = *(const LAS bf16x8*)(kbl + 32 * KP + 32 * (s + 1)); }
    AT_SB;
    st[0] = __builtin_amdgcn_mfma_f32_32x32x16_bf16(a0, qf[s], st[0], 0, 0, 0);
    st[1] = __builtin_amdgcn_mfma_f32_32x32x16_bf16(a1, qf[s], st[1], 0, 0, 0);
    AT_SB;
    a0 = n0; a1 = n1;
  }
}
template <int NDV, int VP>
DI void attn_pv_load0(s16x4 (&l0)[NDV], s16x4 (&h0)[NDV], LAS unsigned char* vbl) {
#pragma unroll
  for (int d = 0; d < NDV; ++d) {
    l0[d] = __builtin_bit_cast(s16x4, __builtin_amdgcn_ds_read_tr16_b64_v4i16((LAS s16x4*)(vbl + d * 64)));
    h0[d] = __builtin_bit_cast(s16x4, __builtin_amdgcn_ds_read_tr16_b64_v4i16((LAS s16x4*)(vbl + 8 * VP + d * 64))); }
}
template <int NDV, int VP, bool PRE>
DI void attn_pv(f32x16 (&o)[NDV], const u32x4 (&pfw)[4], LAS unsigned char* vbl  , s16x4 (&l0)[NDV], s16x4 (&h0)[NDV]) {
  s16x4 l1[NDV], h1[NDV];
#define AT_LD(l, h, b) _Pragma("unroll") for (int d = 0; d < NDV; ++d) { \
    l[d] = __builtin_bit_cast(s16x4, __builtin_amdgcn_ds_read_tr16_b64_v4i16((LAS s16x4*)(vbl + (16 * (b)) * VP + d * 64))); \
    h[d] = __builtin_bit_cast(s16x4, __builtin_amdgcn_ds_read_tr16_b64_v4i16((LAS s16x4*)(vbl + (16 * (b) + 8) * VP + d * 64))); }
#define AT_MM(l, h, b) { const bf16x8 _pf = __builtin_bit_cast(bf16x8, pfw[b]); _Pragma("unroll") for (int d = 0; d < NDV; ++d) \
    o[d] = __builtin_amdgcn_mfma_f32_32x32x16_bf16(__builtin_shufflevector(l[d], h[d], 0, 1, 2, 3, 4, 5, 6, 7), _pf, o[d], 0, 0, 0); }
  if (!PRE) { AT_LD(l0, h0, 0); }
  AT_LD(l1, h1, 1); AT_SB; AT_MM(l0, h0, 0); AT_SB;
  AT_LD(l0, h0, 2); AT_SB; AT_MM(l1, h1, 1); AT_SB;
  AT_LD(l1, h1, 3); AT_SB; AT_MM(l0, h0, 2); AT_SB;
  AT_MM(l1, h1, 3); AT_SB;
#undef AT_LD
#undef AT_MM
}
template <int DQK, int DV, bool BIAS, bool MASK, bool BMM>
DI void attn_item(LAS unsigned char* lds, const bf16_t* Q, int pq, const bf16_t* K, int pk, const bf16_t* V, int pv, bf16_t* O, int po,
                  float* lse, int lse_stride, int q0, int L, int W, float slope2, float m_init, float l_init) {
  constexpr int KP = DQK * 2 + 16, VP = DV * 2 + 64, KBYTES = 64 * KP, VBYTES = 64 * VP, BUF = KBYTES + VBYTES;
  constexpr int KC8 = DQK / 8, VC8 = DV / 8, KCH = 64 * KC8, VCH = 64 * VC8, KPT = (KCH + 511) / 512, VPT = (VCH + 511) / 512;
  constexpr int NS = DQK / 16, NDV = DV / 32;
  int tid = threadIdx.x; asm volatile("" : "+v"(tid));
  const int wid = tid >> 6, lane = tid & 63, r = lane & 31, h = lane >> 5;
  const int qw0 = q0 + 32 * wid, qi = qw0 + r;
  bf16x8 qf[NS];
#pragma unroll
  for (int s = 0; s < NS; ++s) qf[s] = *(const bf16x8*)(Q + (size_t)qi * pq + 16 * s + 8 * h);
  f32x16 o[NDV];
#pragma unroll
  for (int d = 0; d < NDV; ++d)
#pragma unroll
    for (int i = 0; i < 16; ++i) o[d][i] = 0.f;
  float m = m_init, lsum = (h == 0) ? l_init : 0.f;
  u32x4 kext[2]; unsigned cw1 = 0u, cw2 = 0u;
  if (BMM) {
    const unsigned one = 0x3F80u;
#pragma unroll
    for (int b2 = 0; b2 < 2; ++b2) { const unsigned jb = cvt_pk((float)(32 * b2 + r), 0.f) & 0xffffu;
      kext[b2] = (h == 0) ? (u32x4){one | (one << 16), one | (jb << 16), jb | (jb << 16), 0u} : (u32x4){0u, 0u, 0u, 0u}; }
    const unsigned c_hi = cvt_pk(slope2, 0.f) & 0xffffu; const float r1 = slope2 - __uint_as_float(c_hi << 16);
    const unsigned c_mid = cvt_pk(r1, 0.f) & 0xffffu; const float r2 = r1 - __uint_as_float(c_mid << 16); const unsigned c_lo = cvt_pk(r2, 0.f) & 0xffffu;
    cw1 = c_hi << 16; cw2 = c_mid | (c_lo << 16);
  }
  const int klo = (q0 - W > 0 ? q0 - W : 0) >> 6;
  const int khi = ((q0 + 256 + W < L ? q0 + 256 + W : L) + 63) >> 6;
  const int nt = khi - klo;
  u32x4 kreg[KPT], vreg[VPT];
#define AT_GLOAD(kt) do { const int _k0 = (kt) * 64; \
    _Pragma("unroll") for (int _i = 0; _i < KPT; ++_i) { const int _c = tid + _i * 512; if (_c < KCH) { const int _row = _c / KC8, _cc = _c - _row * KC8; kreg[_i] = *(const u32x4*)(K + (size_t)(_k0 + _row) * pk + _cc * 8); } } \
    _Pragma("unroll") for (int _i = 0; _i < VPT; ++_i) { const int _c = tid + _i * 512; if (_c < VCH) { const int _row = _c / VC8, _cc = _c - _row * VC8; vreg[_i] = *(const u32x4*)(V + (size_t)(_k0 + _row) * pv + _cc * 8); } } } while (0)
#define AT_LSTORE(ks, vs_) do { LAS unsigned char* _kb = lds + (ks) * KBYTES; LAS unsigned char* _vb = lds + 2 * KBYTES + (vs_) * VBYTES; \
    _Pragma("unroll") for (int _i = 0; _i < KPT; ++_i) { const int _c = tid + _i * 512; if (_c < KCH) { const int _row = _c / KC8, _cc = _c - _row * KC8; *(LAS u32x4*)(_kb + _row * KP + _cc * 16) = kreg[_i]; } } \
    _Pragma("unroll") for (int _i = 0; _i < VPT; ++_i) { const int _c = tid + _i * 512; if (_c < VCH) { const int _row = _c / VC8, _cc = _c - _row * VC8; *(LAS u32x4*)(_vb + _row * VP + _cc * 16) = vreg[_i]; } } } while (0)
#define AT_PV(vstage) do { s16x4 _l0[NDV], _h0[NDV]; attn_pv<NDV, VP, false>(o, pfw, lds + 2 * KBYTES + (vstage) * VBYTES + vlane_off, _l0, _h0); } while (0)
  AT_GLOAD(klo); AT_LSTORE(0, 0); __syncthreads();
  const int i16 = lane & 15, q4 = i16 >> 2, p4 = i16 & 3, blk = (lane >> 4) & 1;
  const int vlane_off = (4 * h + q4) * VP + (16 * blk + 4 * p4) * 2;
  const bool lag = wid >= 4;
  u32x4 pfw[4]; bool pend = false; int pend_vs = 0, vs = 0;
#pragma unroll
  for (int i = 0; i < 4; ++i) pfw[i] = (u32x4){0u, 0u, 0u, 0u};
  for (int t = 0; t < nt; ++t) {
    const int k0 = (klo + t) * 64;
    if (t + 1 < nt) AT_GLOAD(klo + t + 1);
    const bool active = (k0 + 63 >= qw0 - W) && (k0 <= qw0 + 31 + W);
    if (pend) { AT_PV(pend_vs); pend = false; }
    if (active) {
      LAS unsigned char* kb = lds + (t & 1) * KBYTES;
      f32x16 st[2];
      attn_qk<NS, KP>(st, qf, kb + r * KP + 16 * h);
      const int side = !BMM ? 0 : (k0 + 63 < qw0) ? 1 : (k0 > qw0 + 31) ? -1 : 0;
      if (BMM && side != 0) {
        const float av = (side > 0 ? -slope2 : slope2) * (float)(qi - k0);
        const unsigned a_hi = cvt_pk(av, 0.f) & 0xffffu; const float q1 = av - __uint_as_float(a_hi << 16);
        const unsigned a_mid = cvt_pk(q1, 0.f) & 0xffffu; const float q2 = q1 - __uint_as_float(a_mid << 16); const unsigned a_lo = cvt_pk(q2, 0.f) & 0xffffu;
        const unsigned sg = side > 0 ? 0u : 0x80008000u;
        const u32x4 qe = {a_hi | (a_mid << 16), a_lo | ((cw1 ^ sg) & 0xffff0000u), cw2 ^ sg, 0u};
        const bf16x8 qeb = __builtin_bit_cast(bf16x8, qe);
        st[0] = __builtin_amdgcn_mfma_f32_32x32x16_bf16(__builtin_bit_cast(bf16x8, kext[0]), qeb, st[0], 0, 0, 0);
        st[1] = __builtin_amdgcn_mfma_f32_32x32x16_bf16(__builtin_bit_cast(bf16x8, kext[1]), qeb, st[1], 0, 0, 0);
      }
      s16x4 vl0[NDV], vh0[NDV];
      if (!lag) attn_pv_load0<NDV, VP>(vl0, vh0, lds + 2 * KBYTES + vs * VBYTES + vlane_off);
      if ((BIAS || MASK) && !(BMM && side != 0)) {
        const float basef = (float)(qi - k0 - 4 * h), Wf = (float)W;
#pragma unroll
        for (int b2 = 0; b2 < 2; ++b2)
#pragma unroll
          for (int i = 0; i < 16; ++i) {
            float s = st[b2][i];
            const float df = basef - (float)(32 * b2 + (i & 3) + 8 * (i >> 2));
            if (BIAS) s = s - slope2 * fabsf(df);
            if (MASK) s = (fabsf(df) > Wf) ? -INFINITY : s;
            st[b2][i] = s; }
      }
      float ps = 0.f;
#pragma unroll
      for (int b2 = 0; b2 < 2; ++b2)
#pragma unroll
        for (int i = 0; i < 16; ++i) { const float p = fexp2(st[b2][i]); st[b2][i] = p; ps += p; }
      lsum += ps;
#pragma unroll
      for (int b2 = 0; b2 < 2; ++b2)
#pragma unroll
        for (int s2 = 0; s2 < 2; ++s2) {
          u32x4 pw; pw.x = cvt_pk(st[b2][8 * s2 + 0], st[b2][8 * s2 + 1]); pw.y = cvt_pk(st[b2][8 * s2 + 2], st[b2][8 * s2 + 3]);
          pw.z = cvt_pk(st[b2][8 * s2 + 4], st[b2][8 * s2 + 5]); pw.w = cvt_pk(st[b2][8 * s2 + 6], st[b2][8 * s2 + 7]);
          pfw[b2 * 2 + s2] = pw;
        }
      if (lag) { pend = true; pend_vs = vs; } else { attn_pv<NDV, VP, true>(o, pfw, lds + 2 * KBYTES + vs * VBYTES + vlane_off, vl0, vh0); }
    }
    const int vsn = vs == 2 ? 0 : vs + 1;
    if (t + 1 < nt) AT_LSTORE((t + 1) & 1, vsn);
    __syncthreads();
    vs = vsn;
  }
  if (pend) { AT_PV(pend_vs); }
#undef AT_PV
#undef AT_GLOAD
#undef AT_LSTORE
  const float lt = lsum + __shfl_xor(lsum, 32); const float inv = 1.0f / lt;
#pragma unroll
  for (int d = 0; d < NDV; ++d)
#pragma unroll
    for (int g4 = 0; g4 < 4; ++g4) {
      u32x2 w; w.x = cvt_pk(o[d][4 * g4] * inv, o[d][4 * g4 + 1] * inv); w.y = cvt_pk(o[d][4 * g4 + 2] * inv, o[d][4 * g4 + 3] * inv);
      *(u32x2*)(O + (size_t)qi * po + 32 * d + 8 * g4 + 4 * h) = w;
    }
  if (lse != nullptr && h == 0) lse[(size_t)qi * lse_stride] = m + __log2f(lt);
}


#ifdef DBG
#define WS_DBG (512 * 1024)
DI void dbg_max(unsigned* p, float e) { if (!(e >= 0.f)) e = 1e9f; atomicMax(p, __float_as_uint(e)); }
DI unsigned dbg_hash(unsigned x) { x ^= x >> 16; x *= 0x7feb352du; x ^= x >> 15; x *= 0x846ca68bu; x ^= x >> 16; return x; }
template <int DQK, int DV>
DI float dbg_attn_row(LAS float* sc, const bf16_t* Q, int pq, const bf16_t* K, int pk, const bf16_t* V, int pv, const bf16_t* O, int po,
                      int qi, int L, int W, float slope2, float m_init, float l_init, int lane) {
  float mx = m_init;
  for (int j = lane; j < L; j += 64) {
    int d = qi - j; d = d < 0 ? -d : d; float s = -INFINITY;
    if (d <= W) { s = 0.f; for (int c = 0; c < DQK; ++c) s += bf2f(Q[(size_t)qi * pq + c]) * bf2f(K[(size_t)j * pk + c]); s -= slope2 * (float)d; }
    sc[j] = s; mx = fmaxf(mx, s);
  }
  for (int o = 1; o < 64; o <<= 1) mx = fmaxf(mx, __shfl_xor(mx, o));
  float sum = 0.f;
  for (int j = lane; j < L; j += 64) { const float p = exp2f(sc[j] - mx); sc[j] = p; sum += p; }
  for (int o = 1; o < 64; o <<= 1) sum += __shfl_xor(sum, o);
  sum += l_init * exp2f(m_init - mx);
  float emax = 0.f, rmax = 0.f;
  for (int dv = lane; dv < DV; dv += 64) {
    float acc = 0.f; for (int j = 0; j < L; ++j) acc += sc[j] * bf2f(V[(size_t)j * pv + dv]);
    acc /= sum; const float got = bf2f(O[(size_t)qi * po + dv]);
    emax = fmaxf(emax, fabsf(got - acc)); rmax = fmaxf(rmax, fabsf(acc));
  }
  for (int o = 1; o < 64; o <<= 1) { emax = fmaxf(emax, __shfl_xor(emax, o)); rmax = fmaxf(rmax, __shfl_xor(rmax, o)); }
  return emax / (rmax + 1e-3f);
}
#endif
#define WSP(T, off) ((T*)(ap->ws + (off)))
#define ROPE WSP(float, WS_ROPE)
#define WIN WSP(bf16_t, WS_WIN)
#define WMLA WSP(bf16_t, WS_WMLA)
#define WMEM WSP(bf16_t, WS_WMEM)
#define WBR WSP(bf16_t, WS_WBR)
#define WOUT WSP(bf16_t, WS_WOUT)
#define MN WSP(bf16_t, WS_MN)
#define MKV WSP(bf16_t, WS_MKV)
#define LSE WSP(float, WS_LSE)
#define H WSP(bf16_t, WS_H)
#define QB WSP(bf16_t, WS_QB)
#define KVB WSP(bf16_t, WS_KVB)
#define MLA WSP(bf16_t, WS_MLA)
#define BK WSP(bf16_t, WS_BK)
#define GATE WSP(bf16_t, WS_GATE)
typedef const __attribute__((address_space(4))) Args* CArgsP;
__global__ void __launch_bounds__(512, 2) mega(Args args_unused) {
  extern __shared__ __attribute__((aligned(16))) unsigned char shm_raw[];
  LAS unsigned char* lds = (LAS unsigned char*)shm_raw;
  const int ph_lo = ((CArgsP)__builtin_amdgcn_kernarg_segment_ptr())->ph_lo, ph_hi = ((CArgsP)__builtin_amdgcn_kernarg_segment_ptr())->ph_hi;
  volatile LAS unsigned* xb_st = (volatile LAS unsigned*)(lds + 131072);
  if (threadIdx.x == 0) { xb_st[0] = 0u; xb_st[1] = 0u; }
  __syncthreads();
  const XcdBarrier xbar = xcd_barrier_post((unsigned*)(((CArgsP)__builtin_amdgcn_kernarg_segment_ptr())->ws), xb_st);
  for (int ph = ph_lo; ph < ph_hi; ++ph) {
    CArgsP ap0 = (CArgsP)__builtin_amdgcn_kernarg_segment_ptr(); int phv = ph;
    asm volatile("" : "+s"(ap0), "+s"(phv));
#define PHASE_AP CArgsP ap = ap0; asm volatile("" : "+s"(ap));
    int tid = threadIdx.x; asm volatile("" : "+v"(tid));
    const int wid = tid >> 6, lane = tid & 63;
    int G = gridDim.x, cu = blockIdx.x; asm volatile("" : "+s"(G), "+s"(cu));
    const int l = phv / 31, idx = phv % 31;
    if (idx >= 1 && (idx - 1) % 10 == 2) continue;
    if (idx == 0) {
      PHASE_AP
      LAS float* tile = (LAS float*)lds;
      const int dmask = ap->pad;
      if (dmask & 1) { const float* w = ap->in[5] + (size_t)l * DM * NIN;
        tconv(tile, WIN, DM, NWIN, DM, [&](int k, int n) { const int c = win_src(n); return c < 0 ? 0.f : w[(size_t)k * NIN + c]; }, cu, G); }
      if (dmask & 2) { const float* gcq = ap->in[10] + l * 256; const float* gckv = ap->in[11] + l * 128;
        const float* wq = ap->in[12] + (size_t)l * 256 * 384; const float* wk = ap->in[13] + (size_t)l * 128 * 768;
        tconv(tile, WMLA, 384, PMLA, 384, [&](int k, int n) { if (n < 384) return k < 256 ? wq[k * 384 + n] * gcq[k] : 0.f; if (n < 1152) return k >= 256 ? wk[(k - 256) * 768 + (n - 384)] * gckv[k - 256] : 0.f; return 0.f; }, cu, G); }
      if (dmask & 4) { const float* w = ap->in[22] + (size_t)l * DM * 1024;
        tconv(tile, WMEM, DM, 1024, DM, [&](int k, int n) { return w[(size_t)k * 1024 + n]; }, cu, G); }
      if (dmask & 8) { const float* w = ap->in[26] + (size_t)l * 5 * 512 * 1024;
        tconv(tile, WBR, 512, 5120, 512, [&](int k, int n) { return w[((size_t)(n >> 10) * 512 + k) * 1024 + (n & 1023)]; }, cu, G); }
      if (dmask & 16) { const float* w = ap->in[27] + (size_t)l * DM * DM;
        tconv(tile, WOUT, DM, DM, DM, [&](int k, int n) { return w[(size_t)k * DM + n]; }, cu, G); }
      if (l == 0) {
        const float invf[16] = {1.0f, 0.5623413251903491f, 0.31622776601683794f, 0.1778279410038923f, 0.1f, 0.05623413251903491f, 0.03162277660168379f, 0.01778279410038923f,
                                0.01f, 0.005623413251903491f, 0.0031622776601683794f, 0.001778279410038923f, 0.001f, 0.0005623413251903491f, 0.00031622776601683794f, 0.0001778279410038923f};
        for (int e = cu * 512 + tid; e < 8192 * 16; e += G * 512) {
          const int pos = e >> 4, j = e & 15; float iv = invf[0];
#pragma unroll
          for (int q = 1; q < 16; ++q) iv = (j == q) ? invf[q] : iv;
          const float ang = (float)pos * iv;
          const double rev = (double)ang * 0.15915494309189535; const float fr = (float)(rev - __builtin_rint(rev));
          ROPE[pos * 32 + j] = __builtin_amdgcn_cosf(fr); ROPE[pos * 32 + 16 + j] = __builtin_amdgcn_sinf(fr);
        }
      }
    } else {
      const int u = (idx - 1) / 10, p = (idx - 1) % 10;
      const int S = (u == 0) ? 4096 : 8192, nseq = (u == 0) ? 4 : 2, nmem = nseq * 256;
#define XIN ((l == 0) ? ((u == 0) ? ap->in[0] : ap->in[1] + (size_t)(u - 1) * TU * DM) : ap->out + (size_t)u * TU * DM)
#define XOUT (ap->out + (size_t)u * TU * DM)
#define MEMIN ((u == 0) ? ap->in[2] : ap->in[3] + (size_t)(u - 1) * 512 * DM)
      if (p == 0) {
        PHASE_AP
        const float* xin = XIN; const float* memin = MEMIN;
        const float* g1 = ap->in[4] + l * DM; const float* g2 = ap->in[21] + l * DM;
        for (int row = cu * 8 + wid; row < TU + nmem; row += G * 8) {
          const bool ism = row >= TU; const float* src = ism ? memin + (size_t)(row - TU) * DM : xin + (size_t)row * DM;
          const float* gg = ism ? g2 : g1; bf16_t* dst = ism ? MN + (size_t)(row - TU) * DM : H + (size_t)row * DM;
          f32x4 v[4]; float ss = 0.f;
#pragma unroll
          for (int i = 0; i < 4; ++i) { v[i] = *(const f32x4*)(src + i * 256 + lane * 4); ss += v[i][0] * v[i][0] + v[i][1] * v[i][1] + v[i][2] * v[i][2] + v[i][3] * v[i][3]; }
#pragma unroll
          for (int o = 1; o < 64; o <<= 1) ss += __shfl_xor(ss, o);
          const float rr = rsqrtf(ss * (1.0f / DM) + EPS);
#pragma unroll
          for (int i = 0; i < 4; ++i) { const f32x4 gv = *(const f32x4*)(gg + i * 256 + lane * 4);
            u32x2 w; w.x = cvt_pk(v[i][0] * rr * gv[0], v[i][1] * rr * gv[1]); w.y = cvt_pk(v[i][2] * rr * gv[2], v[i][3] * rr * gv[3]);
            *(u32x2*)(dst + i * 256 + lane * 4) = w; }
        }
      } else if (p == 1) {
        PHASE_AP
        { pg8::GridOrder S_; S_.init(H, DM, WIN, DM, TU, NG1, G, cu); pg8::EpiG1a E{QB, KVB, ap->in[6] + l * 64, ap->in[16] + l * 64, ap->in[19] + l * 64, ap->in[7] + l * 64, ap->in[17] + l * 64, ap->in[20] + l * 64}; pg8::gemm_phase(lds, pg8::Gemm{DM, DM, DM}, S_, E); }
        { pg8::GridOrder S_; S_.init(MN, DM, WMEM, DM, nmem, 1024, G, (cu + 64) % G); pg8::EpiPlain E{MKV, PMKV}; pg8::gemm_phase(lds, pg8::Gemm{DM, DM, DM}, S_, E); }
      } else if (p == 2) {
        PHASE_AP
        const float sc64 = 0.125f * LOG2E, sc128 = 0.08838834764831845f * LOG2E;
        const float* a_qn = ap->in[6] + l * 64; const float* a_kn = ap->in[7] + l * 64; const float* b_cqn = ap->in[10] + l * 256; const float* b_ckvn = ap->in[11] + l * 128;
        const float* b_kn = ap->in[15] + l * 96; const float* c_qn = ap->in[16] + l * 64; const float* c_kn = ap->in[17] + l * 64; const float* d_qn = ap->in[19] + l * 64;
        const float* d_kn = ap->in[20] + l * 64; const float* m_qn = ap->in[23] + l * 128; const float* m_kn = ap->in[24] + l * 128;
        const int c8 = (lane & 7) * 8, c16 = (lane & 15) * 8;
        for (int row = cu * 8 + wid; row < TU + nmem; row += G * 8) {
          if (row >= TU) { bf16_t* pk_ = MKV + (size_t)(row - TU) * PMKV + lane * 8; seg_norm<16>(pk_, pk_, true, m_kn + c16, 1.f, nullptr); continue; }
          bf16_t* qb = QB + (size_t)row * PQ + lane * 8; bf16_t* kv = KVB + (size_t)row * PKV + lane * 8;
          const u32x4 r5 = ldraw(qb + QC_MQ, true), r11 = ldraw(kv + KC_CQ, lane < 32), r12 = ldraw(kv + KC_CKV, lane < 16), r13 = ldraw(kv + KC_KR, lane < 4);
          seg_norm<16>(nullptr, qb + QC_MQ, true, m_qn + c16, sc128, nullptr, &r5);
          seg_norm<32>(nullptr, kv + KC_CQ, lane < 32, b_cqn + (lane & 31) * 8, 1.f, nullptr, &r11);
          seg_norm<16>(nullptr, kv + KC_CKV, lane < 16, b_ckvn + c16, 1.f, nullptr, &r12);
          { float v[8]; seg_norm<4>(nullptr, nullptr, lane < 4, b_kn + 64 + (lane & 3) * 8, 1.f, v, &r13);
            const float* rp = ROPE + (size_t)(row % S) * 32; rope4(v, lane & 3, rp, rp + 16);
            if (lane < 4) *(u32x4*)(kv + KC_KR) = pack8(v); }
        }
      } else if (p == 3) {
        PHASE_AP
        pg8::GridOrder S_; S_.init(KVB + KC_CQ, PKV, WMLA, 384, TU, PMLA, G, cu); pg8::EpiPlain E{MLA, PMLA}; pg8::gemm_phase(lds, pg8::Gemm{PKV, 384, 384}, S_, E);
      } else if (p == 4) {
        PHASE_AP
        const float scb = 0.10206207261596575f * LOG2E, sc128 = 0.08838834764831845f * LOG2E;
        const float* b_qn = ap->in[14] + l * 96; const float* b_kn = ap->in[15] + l * 96; const float* m_qn = ap->in[23] + l * 128; const float* m_kn = ap->in[24] + l * 128;
        const int c16 = (lane & 15) * 8;
        for (int row = cu * 8 + wid; row < TU + nmem; row += G * 8) {
          if (row >= TU) { bf16_t* pk_ = MKV + (size_t)(row - TU) * PMKV + lane * 8; seg_norm<16>(pk_, pk_, true, m_kn + c16, 1.f, nullptr); continue; }
          bf16_t* ml = MLA + (size_t)row * PMLA; bf16_t* bk = BK + (size_t)row * PBK; const bf16_t* kvrow = KVB + (size_t)row * PKV; bf16_t* pmq = QB + (size_t)row * PQ + QC_MQ + lane * 8;
          const float* rp = ROPE + (size_t)(row % S) * 32;
          const int hd8 = (lane >> 3) & 3, ch8 = lane & 7, hd4 = (lane >> 2) & 3, ch4 = lane & 3;
          bf16_t* pqn = ml + hd8 * 96 + ch8 * 8; bf16_t* pqr = ml + hd4 * 96 + 64 + ch4 * 8; bf16_t* pv_ = ml + 384 + (lane >> 4) * 192 + 64 + c16;
          const u32x4 rcq = ldraw(kvrow + KC_CQ + lane * 8, lane < 32), rckv = ldraw(kvrow + KC_CKV + lane * 8, lane < 16), rkr = ldraw(kvrow + KC_KR + ch4 * 8, lane < 16), rmq = ldraw(pmq, true),
                      q0r = ldraw(pqn, lane < 32), q1r = ldraw(pqr, lane < 16), q2r = ldraw(ml + 384 + hd8 * 192 + ch8 * 8, lane < 32), rvv = ldraw(pv_, true);
          float sq = 0.f, skv = 0.f;
          { float t8[8]; unpack8(rcq, t8);
#pragma unroll
            for (int i = 0; i < 8; ++i) sq += t8[i] * t8[i];
            unpack8(rckv, t8);
#pragma unroll
            for (int i = 0; i < 8; ++i) skv += t8[i] * t8[i]; }
#pragma unroll
          for (int o = 1; o < 64; o <<= 1) { sq += __shfl_xor(sq, o); skv += __shfl_xor(skv, o); }
          const float r_q = rsqrtf(sq * (1.0f / 256.0f) + EPS), r_kv = rsqrtf(skv * (1.0f / 128.0f) + EPS);
          seg_norm<8>(nullptr, pqn, lane < 32, b_qn + ch8 * 8, scb, nullptr, &q0r, r_q);
          { float v[8]; seg_norm<4>(nullptr, nullptr, lane < 16, b_qn + 64 + ch4 * 8, 1.f, v, &q1r, r_q);
            rope4(v, ch4, rp, rp + 16);
#pragma unroll
            for (int i = 0; i < 8; ++i) v[i] *= scb;
            if (lane < 16) *(u32x4*)pqr = pack8(v); }
          seg_norm<8>(nullptr, bk + hd8 * 96 + ch8 * 8, lane < 32, b_kn + ch8 * 8, 1.f, nullptr, &q2r, r_kv);
          { float v[8]; seg_norm<4>(nullptr, nullptr, lane < 16, b_kn + 64 + ch4 * 8, 1.f, v, &rkr);
            rope4(v, ch4, rp, rp + 16);
            if (lane < 16) *(u32x4*)(bk + hd4 * 96 + 64 + ch4 * 8) = pack8(v); }
          { float v[8]; unpack8(rvv, v);
#pragma unroll
            for (int i = 0; i < 8; ++i) v[i] *= r_kv;
            *(u32x4*)pv_ = pack8(v); }
          seg_norm<16>(nullptr, pmq, true, m_qn + c16, sc128, nullptr, &rmq);
        }
      } else if (p == 5) {
        PHASE_AP
        const int nqb = S / 256, per = nseq * nqb;
        const int nB = per * 4, nA = per * 8, nC = per * 8, nD = per * 24, nM = per * 4, ntot = nB + nA + nC + nD + nM;
        const float* sink = ap->in[18] + l * 8;
        const int BIGW = 1 << 28;
        float gq = fabsf((ap->in[6] + l * 64)[lane]), gk = fabsf((ap->in[7] + l * 64)[lane]);
#pragma unroll
        for (int o = 1; o < 64; o <<= 1) { gq = fmaxf(gq, __shfl_xor(gq, o)); gk = fmaxf(gk, __shfl_xor(gk, o)); }
        const float athr = 2.0f * (8.0f * gq * gk * 1.02f) + 104.0f;
        float gbq = fmaxf(fabsf((ap->in[14] + l * 96)[lane]), fabsf((ap->in[14] + l * 96)[64 + (lane & 31)])), gbk = fmaxf(fabsf((ap->in[15] + l * 96)[lane]), fabsf((ap->in[15] + l * 96)[64 + (lane & 31)]));
        float gcq = fabsf((ap->in[16] + l * 64)[lane]), gck = fabsf((ap->in[17] + l * 64)[lane]), gdq = fabsf((ap->in[19] + l * 64)[lane]), gdk = fabsf((ap->in[20] + l * 64)[lane]);
        float gmq = fmaxf(fabsf((ap->in[23] + l * 128)[lane]), fabsf((ap->in[23] + l * 128)[64 + lane])), gmk = fmaxf(fabsf((ap->in[24] + l * 128)[lane]), fabsf((ap->in[24] + l * 128)[64 + lane]));
#pragma unroll
        for (int o = 1; o < 64; o <<= 1) { gbq = fmaxf(gbq, __shfl_xor(gbq, o)); gbk = fmaxf(gbk, __shfl_xor(gbk, o)); gcq = fmaxf(gcq, __shfl_xor(gcq, o)); gck = fmaxf(gck, __shfl_xor(gck, o));
          gdq = fmaxf(gdq, __shfl_xor(gdq, o)); gdk = fmaxf(gdk, __shfl_xor(gdk, o)); gmq = fmaxf(gmq, __shfl_xor(gmq, o)); gmk = fmaxf(gmk, __shfl_xor(gmk, o)); }
        const float smA = 8.0f * gq * gk * (LOG2E * 1.02f), smB = 9.797959f * gbq * gbk * (LOG2E * 1.02f), smC = 8.0f * gcq * gck * (LOG2E * 1.02f),
                    smD = 8.0f * gdq * gdk * (LOG2E * 1.02f), smM = 11.313708f * gmq * gmk * (LOG2E * 1.02f);
        unsigned* qctr = (unsigned*)(ap->ws + 32768) + (l * 3 + u) * 64;
        volatile LAS unsigned* qslot = (volatile LAS unsigned*)(lds + 131072 + 16);
        for (;;) {
          __syncthreads();
          if (tid == 0) qslot[0] = atomicAdd(qctr, 1u);
          __syncthreads();
          const int it = (int)qslot[0];
          if (it >= ntot) break;
          int j = it;
          if (j < nB) {
            const int blk = j % nqb, hh = (j / nqb) % 4, b = j / (nqb * 4); const size_t r0 = (size_t)b * S;
            attn_item<96, 128, false, false, false>(lds, MLA + r0 * PMLA + hh * 96, PMLA, BK + r0 * PBK + hh * 96, PBK, MLA + r0 * PMLA + 384 + hh * 192 + 64, PMLA,
                               QB + r0 * PQ + QC_OB + hh * 128, PQ, nullptr, 0, blk * 256, S, BIGW, 0.f, 0.f, 0.f);
            continue; }
          j -= nB;
          if (j < nA) {
            const int blk = j % nqb, mm = (j / nqb) & 1, b = (j / (nqb * 2)) % nseq, hh = 3 - j / (nqb * 2 * nseq); const size_t r0 = (size_t)b * S;
            const float sn = exp2f(-2.0f * (hh + 1)), slope = sn * LOG2E; const float wf = athr / sn + 2.0f; const int Wa = wf > 1e8f ? BIGW : (int)wf;
            attn_item<64, 128, true, false, true>(lds, QB + r0 * PQ + QC_AQ + mm * 256 + hh * 64, PQ, KVB + r0 * PKV + KC_AK + mm * 256 + hh * 64, PKV, KVB + r0 * PKV + KC_AV + hh * 128, PKV,
                               QB + r0 * PQ + QC_OA + mm * 512 + hh * 128, PQ, nullptr, 0, blk * 256, S, Wa, slope, 0.f, 0.f);
            continue; }
          j -= nA;
          if (j < nC) {
            const int blk = j % nqb, hq = (j / nqb) % 8, b = j / (nqb * 8), kvh = hq >> 2; const size_t r0 = (size_t)b * S;
            const float slope = exp2f(-(float)(hq + 1)) * LOG2E; const float sk2 = sink[hq] * LOG2E, mC = fmaxf(smC, sk2);
            attn_item<64, 64, true, true, false>(lds, QB + r0 * PQ + QC_CQ + hq * 64, PQ, KVB + r0 * PKV + KC_CK + kvh * 64, PKV, KVB + r0 * PKV + KC_CV + kvh * 64, PKV,
                              QB + r0 * PQ + QC_CQ + hq * 64, PQ, nullptr, 0, blk * 256, S, 128, slope, 0.f, exp2f(sk2));
            continue; }
          j -= nC;
          if (j < nD) {
            const int blk = j % nqb, gh = (j / nqb) % 24, b = j / (nqb * 24), gg = gh >> 3, hh = gh & 7;
            const int dil = gg == 0 ? 1 : gg == 1 ? 4 : 16; const int Ls = S / dil, nbr = Ls / 256, res = blk / nbr, qbk = blk % nbr;
            const size_t r0 = (size_t)b * S + res; const float slope = exp2f(-(float)(hh + 1)) * LOG2E * (float)dil;
            attn_item<64, 64, true, true, false>(lds, QB + r0 * PQ + QC_DQ + gg * 512 + hh * 64, PQ * dil, KVB + r0 * PKV + KC_DK + gg * 512 + hh * 64, PKV * dil, KVB + r0 * PKV + KC_DV + gg * 512 + hh * 64, PKV * dil,
                              QB + r0 * PQ + QC_DQ + gg * 512 + hh * 64, PQ * dil, LSE + r0 * 24 + gg * 8 + hh, 24 * dil, qbk * 256, Ls, 64, slope, 0.f, 0.f);
            continue; }
          j -= nD;
          { const int blk = j % nqb, hh = (j / nqb) % 4, b = j / (nqb * 4); const size_t r0 = (size_t)b * S;
            attn_item<128, 128, false, false, false>(lds, QB + r0 * PQ + QC_MQ + hh * 128, PQ, MKV + (size_t)b * 256 * PMKV + hh * 128, PMKV, MKV + (size_t)b * 256 * PMKV + 512 + hh * 128, PMKV,
                                QB + r0 * PQ + QC_MQ + hh * 128, PQ, nullptr, 0, blk * 256, 256, BIGW, 0.f, 0.f, 0.f); }
        }
      } else if (p == 6) {
        PHASE_AP
        const float* lf = ap->in[8] + l * 256; const float* a_hn = ap->in[9] + l * 128;
        float d01 = lf[lane] * lf[64 + lane], d23 = lf[128 + lane] * lf[192 + lane];
#pragma unroll
        for (int o = 1; o < 64; o <<= 1) { d01 += __shfl_xor(d01, o); d23 += __shfl_xor(d23, o); }
        const float lam_init = 0.8f - 0.6f * expf(-0.3f * (float)l);
        const float lam = expf(d01) - expf(d23) + lam_init;
        const int c16 = (lane & 15) * 8;
        for (int row = cu * 8 + wid; row < TU; row += G * 8) {
          bf16_t* qb = QB + (size_t)row * PQ;
          bf16_t* pA = qb + QC_OA + lane * 8; bf16_t* pD = qb + QC_DQ + lane * 8;
          const u32x4 ra0 = *(const u32x4*)pA, ra1 = *(const u32x4*)(pA + 512), rd0 = *(const u32x4*)pD, rd1 = *(const u32x4*)(pD + 512), rd2 = *(const u32x4*)(pD + 1024);
          const int hd = lane >> 3; const float* ls = LSE + (size_t)row * 24 + hd; const float l0 = ls[0], l1 = ls[8], l2 = ls[16];
          { float a0[8], a1[8]; unpack8(ra0, a0); unpack8(ra1, a1);
            float ss = 0.f;
#pragma unroll
            for (int i = 0; i < 8; ++i) { a0[i] = a0[i] - lam * a1[i]; ss += a0[i] * a0[i]; }
#pragma unroll
            for (int o = 1; o < 16; o <<= 1) ss += __shfl_xor(ss, o);
            const float rr = rsqrtf(ss * (1.0f / 128.0f) + EPS) * (1.0f - lam_init);
#pragma unroll
            for (int i = 0; i < 8; ++i) a0[i] = a0[i] * rr * a_hn[c16 + i];
            *(u32x4*)pA = pack8(a0); }
          { const float mx = fmaxf(l0, fmaxf(l1, l2)); float w0 = fexp2(l0 - mx), w1 = fexp2(l1 - mx), w2 = fexp2(l2 - mx); const float iw = 1.0f / (w0 + w1 + w2);
            w0 *= iw; w1 *= iw; w2 *= iw;
            float a0[8], a1[8], a2[8]; unpack8(rd0, a0); unpack8(rd1, a1); unpack8(rd2, a2);
#pragma unroll
            for (int i = 0; i < 8; ++i) a0[i] = w0 * a0[i] + w1 * a1[i] + w2 * a2[i];
            *(u32x4*)pD = pack8(a0); }
        }
        __syncthreads();
        { pg8::GridOrder S_; S_.init(H, DM, WIN + (size_t)(NG1 + NZ) * DM, DM, TU, NGT, G, cu); pg8::EpiGate E{GATE, ap->in[25] + (size_t)l * 5 * DM}; pg8::gemm_phase(lds, pg8::Gemm{DM, DM, DM}, S_, E); }
      } else if (p == 7) {
        PHASE_AP
        pg8::GridOrder S_; S_.init(H, DM, WIN + (size_t)NG1 * DM, DM, TU, NZ, G, cu); pg8::EpiZ E{QB}; pg8::gemm_phase(lds, pg8::Gemm{DM, DM, DM}, S_, E);
      } else if (p == 8) {
        PHASE_AP
        pg8::MergeOrder S_{(const char*)QB, (const char*)WBR, (TU / 256) * 4, G, cu}; pg8::EpiMerge E{H, GATE, (ap->pad >> 8) & 31}; pg8::gemm_phase(lds, pg8::Gemm{PQ, 512, 512}, S_, E);
      } else {
        PHASE_AP
        const float* xin = XIN; float* xout = XOUT;
        pg8::GridOrder S_; S_.init(H, DM, WOUT, DM, TU, DM, G, cu); pg8::EpiOut E{xin, xout}; pg8::gemm_phase(lds, pg8::Gemm{DM, DM, DM}, S_, E);
      }
    }
    if (ap0->coop && ph + 1 < ph_hi) { if (ap0->coop == 2) grid_sync(); else xcd_barrier(xbar); }
#ifdef DBG
    {
      CArgsP ap = ap0; unsigned* DB = (unsigned*)(ap->ws + WS_DBG);
      int tid = threadIdx.x; const int lane = tid & 63, wid = tid >> 6; const int G = gridDim.x, cu = blockIdx.x;
      if (ph + 1 >= ph_hi) grid_sync();
      if (ph == 0) { if (cu == 0 && tid < 16) DB[tid] = 0u; }
      if (ph == 2) {
        for (int s = cu * 512 + tid; s < 32768; s += G * 512) {
          const unsigned hsh = dbg_hash(s * 2654435761u + 17u); const int t = hsh % TU, n = (hsh >> 14) % (NG1 - 96);
          float ref = 0.f; for (int k = 0; k < DM; ++k) ref += bf2f(H[(size_t)t * DM + k]) * bf2f(WIN[(size_t)n * DM + k]);
          const float got = n < 3072 ? bf2f(QB[(size_t)t * PQ + n]) : bf2f(KVB[(size_t)t * PKV + n - 3072]);
          dbg_max(DB + 0, fabsf(got - ref) / (fabsf(ref) + 0.05f));
        }
        for (int s = cu * 512 + tid; s < 8192; s += G * 512) {
          const unsigned hsh = dbg_hash(s * 2654435761u + 99u); const int t = hsh % 1024, n = (hsh >> 14) % 1024;
          float ref = 0.f; for (int k = 0; k < DM; ++k) ref += bf2f(MN[(size_t)t * DM + k]) * bf2f(WMEM[(size_t)n * DM + k]);
          dbg_max(DB + 3, fabsf(bf2f(MKV[(size_t)t * PMKV + n]) - ref) / (fabsf(ref) + 0.05f));
        }
      }
      if (ph == 4) {
        for (int s = cu * 512 + tid; s < 32768; s += G * 512) {
          const unsigned hsh = dbg_hash(s * 2654435761u + 5u); const int t = hsh % TU, n = (hsh >> 14) % 1152;
          float ref = 0.f; for (int k = 0; k < 384; ++k) ref += bf2f(KVB[(size_t)t * PKV + KC_CQ + k]) * bf2f(WMLA[(size_t)n * 384 + k]);
          dbg_max(DB + 4, fabsf(bf2f(MLA[(size_t)t * PMLA + n]) - ref) / (fabsf(ref) + 0.05f));
        }
      }
      if (ph == 6) {
        const int S = 4096, nqb = 16, per = 64, nB = per * 4, nA = per * 8; LAS float* sc = (LAS float*)lds;
        if (wid == 0) for (int it = cu; it < nB + nA; it += G) {
          const int rq = (it * 97 + 13) & 255; float e;
          if (it < nB) { const int j = it, blk = j % nqb, hh = (j / nqb) % 4, b = j / (nqb * 4); const size_t r0 = (size_t)b * S;
            e = dbg_attn_row<96, 128>(sc, MLA + r0 * PMLA + hh * 96, PMLA, BK + r0 * PBK + hh * 96, PBK, MLA + r0 * PMLA + 384 + hh * 192 + 64, PMLA, QB + r0 * PQ + QC_OB + hh * 128, PQ,
                                      blk * 256 + rq, S, 1 << 28, 0.f, -1e30f, 0.f, lane);
            if (lane == 0) dbg_max(DB + 2, e);
          } else { const int j = it - nB, blk = j % nqb, mh = (j / nqb) % 8, b = j / (nqb * 8), mm = mh >> 2, hh = mh & 3; const size_t r0 = (size_t)b * S;
            const float slope = exp2f(-2.0f * (hh + 1)) * LOG2E;
            e = dbg_attn_row<64, 128>(sc, QB + r0 * PQ + QC_AQ + mm * 256 + hh * 64, PQ, KVB + r0 * PKV + KC_AK + mm * 256 + hh * 64, PKV, KVB + r0 * PKV + KC_AV + hh * 128, PKV,
                                      QB + r0 * PQ + QC_OA + mm * 512 + hh * 128, PQ, blk * 256 + rq, S, 1 << 28, slope, -1e30f, 0.f, lane);
            if (lane == 0) dbg_max(DB + 1, e);
          }
        }
      }
      if (ph == 7) {
        const float* bg = ap->in[25];
        for (int s = cu * 512 + tid; s < 32768; s += G * 512) {
          const unsigned hsh = dbg_hash(s * 2654435761u + 7u); const int t = hsh % TU, n = (hsh >> 14) % NGT;
          float ref = 0.f; for (int k = 0; k < DM; ++k) ref += bf2f(H[(size_t)t * DM + k]) * bf2f(WIN[(size_t)(NG1 + NZ + n) * DM + k]);
          ref = 1.f / (1.f + expf(-(ref + bg[n])));
          dbg_max(DB + 8, fabsf(bf2f(GATE[(size_t)t * PGATE + n]) - ref) / (fabsf(ref) + 0.05f));
        }
      }
      if (ph == 9) {
        for (int s = cu * 512 + tid; s < 32768; s += G * 512) {
          const unsigned hsh = dbg_hash(s * 2654435761u + 9u); const int t = hsh % TU, c = (hsh >> 14) % DM;
          float ref = 0.f;
          for (int br = 0; br < 5; ++br) { const int ocol = br == 0 ? QC_OA : br == 1 ? QC_OB : br == 2 ? QC_CQ : br == 3 ? QC_DQ : QC_MQ;
            float tt = 0.f; for (int k = 0; k < 512; ++k) tt += bf2f(QB[(size_t)t * PQ + ocol + k]) * bf2f(WBR[(size_t)(br * 1024 + c) * 512 + k]);
            ref += bf2f(GATE[(size_t)t * PGATE + br * 1024 + c]) * tt; }
          dbg_max(DB + 9, fabsf(bf2f(H[(size_t)t * DM + c]) - ref) / (fabsf(ref) + 0.05f));
        }
      }
      if (ph == 10) {
        for (int s = cu * 512 + tid; s < 32768; s += G * 512) {
          const unsigned hsh = dbg_hash(s * 2654435761u + 11u); const int t = hsh % TU, c = (hsh >> 14) % DM;
          float ref = 0.f; for (int k = 0; k < DM; ++k) ref += bf2f(H[(size_t)t * DM + k]) * bf2f(WOUT[(size_t)c * DM + k]);
          ref += ap->in[0][(size_t)t * DM + c];
          dbg_max(DB + 10, fabsf(ap->out[(size_t)t * DM + c] - ref) / (fabsf(ref) + 0.05f));
        }
      }
      if (ph == 2 || ph == 4 || ph == 6 || ph == 0 || ph == 7 || ph == 9) grid_sync();
      if (ph + 1 == ph_hi) {
        grid_sync();
        const float e1 = __uint_as_float(DB[DBG_SEL1]), e2 = __uint_as_float(DB[DBG_SEL2]);
        const float k1 = fminf(fmaxf(log10f(e1 + 1e-30f) + 5.f, 0.f), 7.f), k2 = fminf(fmaxf(log10f(e2 + 1e-30f) + 5.f, 0.f), 7.f);
        for (size_t i = (size_t)cu * 512 + tid; i < (size_t)49152 * DM; i += (size_t)G * 512) {
          const float xv = i < (size_t)TU * DM ? ap->in[0][i] : ap->in[1][i - (size_t)TU * DM];
          ap->out[i] = (i == 0) ? 100.f * k2 : xv * (1.f + k1);
        }
      }
    }
#endif
  }
}

extern "C" void kernel_launch(void* const* d_in, const int* in_sizes, int n_in, void* d_out, int out_size, void* d_ws, size_t ws_size, hipStream_t stream) {
  static int grid = 0;
  if (!grid) {
    if (n_in != 28 || ws_size < WS_END) { fprintf(stderr, "kernel_launch: unexpected n_in %d or ws_size %zu (< %zu)\n", n_in, ws_size, (size_t)WS_END); grid = -1; }
    else {
      int dev = 0, cus = 0, per_cu = 0;
      hipGetDevice(&dev); hipDeviceGetAttribute(&cus, hipDeviceAttributeMultiprocessorCount, dev);
      hipFuncSetAttribute((const void*)mega, hipFuncAttributeMaxDynamicSharedMemorySize, LDS_BYTES);
      hipOccupancyMaxActiveBlocksPerMultiprocessor(&per_cu, mega, 512, LDS_BYTES);
      grid = cus * (per_cu > 0 ? 1 : 0);
      if (grid > 256) grid = 256;
      if (grid <= 0) { fprintf(stderr, "kernel_launch: occupancy query says %d blocks/CU\n", per_cu); grid = -1; }
    }
  }
  if (grid <= 0) return;
  Args a{};
  for (int i = 0; i < 28; ++i) a.in[i] = (const float*)d_in[i];
  a.out = (float*)d_out; a.ws = (unsigned char*)d_ws; a.ph_lo = 0; a.ph_hi = DBG_PH_HI; a.coop = 1; a.pad = 31 | (DBG_BMASK << 8);
  if (hipMemsetAsync(d_ws, 0, 65536, stream) != hipSuccess) { fprintf(stderr, "kernel_launch: memset of barrier words failed\n"); return; }
  void* params[] = {&a};
  hipError_t e = hipLaunchCooperativeKernel((const void*)mega, dim3(grid), dim3(512), params, LDS_BYTES, stream);
  if (e != hipSuccess) fprintf(stderr, "cooperative launch failed: %s (grid %d)\n", hipGetErrorString(e), grid);
}
```

```cpp
#include <hip/hip_runtime.h>
#include <hip/hip_cooperative_groups.h>
#include <cstdio>
#include <cstdint>
namespace cg = cooperative_groups;

#define LAS __attribute__((address_space(3)))
#define DI __device__ __forceinline__
typedef unsigned short bf16_t;
typedef short bf16x8 __attribute__((ext_vector_type(8)));
typedef short s16x4 __attribute__((ext_vector_type(4)));
typedef float f32x4 __attribute__((ext_vector_type(4)));
typedef float f32x16 __attribute__((ext_vector_type(16)));
typedef unsigned u32x4 __attribute__((ext_vector_type(4)));
typedef unsigned u32x2 __attribute__((ext_vector_type(2)));

constexpr int DM = 1024, NIN = 15520, TU = 16384  , NUNIT = 3, DEPTH = 2;
constexpr int PQ = 4608, PKV = 4864, PMLA = 1280, PBK = 384, PGATE = 5120, PMKV = 1024;
constexpr int NG1 = 7936, NZ = 2560, NGT = 5120, NWIN = NG1 + NZ + NGT;
constexpr float LOG2E = 1.4426950408889634f, EPS = 1e-6f;
constexpr int QC_AQ = 0, QC_CQ = 512, QC_DQ = 1024, QC_MQ = 2560, QC_OA = 3072, QC_OB = 4096;
constexpr int KC_AK = 0, KC_AV = 512, KC_CK = 1024, KC_CV = 1152, KC_DK = 1280, KC_DV = 2816, KC_CQ = 4352, KC_CKV = 4608, KC_KR = 4736;
constexpr size_t MiB = 1u << 20;
constexpr size_t WS_ROPE = 1 * MiB, WS_WIN = 2 * MiB, WS_WMLA = 33 * MiB, WS_WMEM = 34 * MiB, WS_WBR = 38 * MiB, WS_WOUT = 43 * MiB,
                 WS_MN = 45 * MiB, WS_MKV = 47 * MiB, WS_LSE = 51 * MiB, WS_H = 54 * MiB, WS_QB = 86 * MiB, WS_KVB = 230 * MiB,
                 WS_MLA = 382 * MiB, WS_BK = 422 * MiB, WS_GATE = 230 * MiB, WS_END = 434 * MiB;
constexpr int LDS_BYTES = 131072 + 256;

#define DBG_SEL1 9
#define DBG_SEL2 10
#ifdef DBG
#define DBG_PH_HI 11
#else
#define DBG_PH_HI 62
#endif
#ifndef DBG_BMASK
#define DBG_BMASK 31
#endif
struct Args { const float* in[28]; float* out; unsigned char* ws; int ph_lo, ph_hi, coop, pad; };

DI float bf2f(unsigned short b) { return __uint_as_float(((unsigned)b) << 16); }
typedef __bf16 bf16x2_t __attribute__((ext_vector_type(2)));
typedef float f32x2_t __attribute__((ext_vector_type(2)));
DI unsigned cvt_pk(float lo, float hi) { const f32x2_t v = {lo, hi}; const bf16x2_t b = __builtin_convertvector(v, bf16x2_t); return __builtin_bit_cast(unsigned, b); }
DI void unpack8(const u32x4 w, float* v) {
#pragma unroll
  for (int i = 0; i < 4; ++i) { v[2 * i] = __uint_as_float(w[i] << 16); v[2 * i + 1] = __uint_as_float(w[i] & 0xffff0000u); }
}
DI u32x4 pack8(const float* v) { u32x4 w; w.x = cvt_pk(v[0], v[1]); w.y = cvt_pk(v[2], v[3]); w.z = cvt_pk(v[4], v[5]); w.w = cvt_pk(v[6], v[7]); return w; }
DI float fexp2(float x) { return __builtin_amdgcn_exp2f(x); }
DI float sigmoidf_(float x) { return __builtin_amdgcn_rcpf(1.0f + fexp2(-x * LOG2E)); }

namespace pg8 {
constexpr int BM = 256, BK = 64, HALF = 128, HTB = HALF * BK * 2, NXCD = 8, WGM = 8;
__host__ __device__ __forceinline__ int lds_byte(int r, int c) { const int st = (r >> 4) * 2 + (c >> 5), rr = r & 15, cc = c & 31, ob = rr * 64 + cc * 2; return st * 1024 + (ob ^ (((ob >> 9) & 1) << 5)); }
__host__ __device__ __forceinline__ void stage_rc(int b, int& R, int& C) { const int st = b / 1024, sb = b % 1024, swz = sb ^ (((sb >> 9) & 1) << 5); R = (st >> 1) * 16 + swz / 64; C = (st & 1) * 32 + (swz % 64) / 2; }
__host__ __device__ __forceinline__ int perm32(int rho) { const int n = rho >> 4, i = rho & 15; return 8 * (i >> 2) + 4 * n + (i & 3); }

struct Unit { const char* a; const char* b; int pm, pn, aux; };
struct Gemm { int lda, ldb, K; };

struct GridOrder {
  const char* A; const char* B; int lda, ldb, nM, nN, nwg, G, c;
  DI void init(const void* A_, int lda_, const void* B_, int ldb_, int M, int N, int G_, int c_) { A = (const char*)A_; B = (const char*)B_; lda = lda_; ldb = ldb_; nM = M / BM; nN = N / BM; nwg = nM * nN; G = G_; c = c_; }
  DI bool next(int i, Unit& u) const {
    const long L = (long)i * G + c; if (L >= nwg) return false;
    int wgid = (int)L; { const int q = nwg / NXCD, r = nwg % NXCD, xcd = wgid % NXCD, off = wgid / NXCD; wgid = (xcd < r ? xcd * (q + 1) : r * (q + 1) + (xcd - r) * q) + off; }
    const int nig = WGM * nN, gid = wgid / nig, fm = gid * WGM, gsz = (nM - fm) < WGM ? (nM - fm) : WGM;
    u.pm = fm + ((wgid % nig) % gsz); u.pn = (wgid % nig) / gsz; u.aux = 0;
    u.a = A + (size_t)u.pm * BM * lda * 2; u.b = B + (size_t)u.pn * BM * ldb * 2; return true;
  }
};
struct MergeOrder {
  const char* QBp; const char* WBR; int ntiles, G, c;
  DI bool next(int i, Unit& u) const {
    const int k = i / 5, br = i - k * 5; const int tile = c + k * G; if (tile >= ntiles) return false;
    u.pm = tile % (ntiles >> 2); u.pn = tile / (ntiles >> 2); u.aux = br;
    const int ocol = br == 0 ? QC_OA : br == 1 ? QC_OB : br == 2 ? QC_CQ : br == 3 ? QC_DQ : QC_MQ;
    u.a = QBp + ((size_t)u.pm * BM * PQ + ocol) * 2; u.b = WBR + ((size_t)(br * 1024 + u.pn * BM) * 512) * 2; return true;
  }
};

template <class Epi, class Sched>
DI void gemm_phase(LAS unsigned char* lds, const Gemm g, const Sched& S, const Epi& E) {
  int tid = threadIdx.x; asm volatile("" : "+v"(tid));
  const int wid = __builtin_amdgcn_readfirstlane(tid >> 6), lane = tid & 63, wr = wid >> 2, wc = wid & 3, fr = lane & 15, fq = lane >> 4;
  const int K = g.K, nt = K / BK;
  unsigned voffA[2], voffB[2];
#pragma unroll
  for (int i = 0; i < 2; ++i) { int R, C; stage_rc(tid * 16 + i * 8192, R, C); const int Rb = (R & ~31) + perm32(R & 31);
    voffA[i] = (unsigned)(R * g.lda + C) * 2u; voffB[i] = (unsigned)(Rb * g.ldb + C) * 2u; }
  const size_t kstep = (size_t)(BK * 2);
  const size_t hstepA = (size_t)HALF * g.lda * 2, hstepB = (size_t)HALF * g.ldb * 2;
  const unsigned ldsw = (unsigned)wid * 1024u;
  const int aoff = lds_byte(wr * 64 + fr, fq * 8), boff = lds_byte(wc * 32 + fr, fq * 8);
#define PG8_SA(b, h) (((b) * 2 + (h)) * HTB)
#define PG8_SB(b, h) ((4 + (b) * 2 + (h)) * HTB)
#define PG8_STAGE(bufoff, gbase, voff) do { _Pragma("unroll") for (int _i = 0; _i < 2; ++_i) \
    __builtin_amdgcn_global_load_lds((const unsigned*)((const char*)(gbase) + (voff)[_i]), (LAS unsigned*)(lds + (bufoff) + ldsw + _i * 8192), 16, 0, 0); } while (0)
#define PG8_LDA(dst, b, h) do { _Pragma("unroll") for (int m = 0; m < 4; ++m) _Pragma("unroll") for (int k = 0; k < 2; ++k) dst[m][k] = *(const LAS bf16x8*)(lds + PG8_SA(b, h) + aoff + m * 2048 + k * 1024); } while (0)
#define PG8_LDB(dst, b, h) do { _Pragma("unroll") for (int n = 0; n < 2; ++n) _Pragma("unroll") for (int k = 0; k < 2; ++k) dst[n][k] = *(const LAS bf16x8*)(lds + PG8_SB(b, h) + boff + n * 2048 + k * 1024); } while (0)
#define PG8_MMA(ai, bj, At, Bt) do { __builtin_amdgcn_s_setprio(1); _Pragma("unroll") for (int m = 0; m < 4; ++m) _Pragma("unroll") for (int n = 0; n < 2; ++n) _Pragma("unroll") for (int k = 0; k < 2; ++k) \
    acc[ai][bj][m][n] = __builtin_amdgcn_mfma_f32_16x16x32_bf16(Bt[n][k], At[m][k], acc[ai][bj][m][n], 0, 0, 0); __builtin_amdgcn_s_setprio(0); } while (0)
#define PG8_WAIT_V(n) asm volatile("s_waitcnt vmcnt(" #n ")" ::: "memory")
#define PG8_WAIT_L(n) asm volatile("s_waitcnt lgkmcnt(" #n ")" ::: "memory")
#define PG8_BAR __builtin_amdgcn_s_barrier()
#define PG8_SCHED __builtin_amdgcn_sched_barrier(0)
  Unit cur, nxt; int ui = 0;
  if (!S.next(0, cur)) return;
  f32x4 acc[2][2][4][2];
#pragma unroll
  for (int a = 0; a < 2; ++a)
#pragma unroll
    for (int b = 0; b < 2; ++b)
#pragma unroll
      for (int m = 0; m < 4; ++m)
#pragma unroll
        for (int n = 0; n < 2; ++n) acc[a][b][m][n] = (f32x4){0.f, 0.f, 0.f, 0.f};
  bf16x8 At[4][2], B0[2][2], B1[2][2];
  const char* cA = cur.a; const char* cB = cur.b;
  PG8_STAGE(PG8_SB(0, 0), cB, voffB); PG8_STAGE(PG8_SB(0, 1), cB + hstepB, voffB); PG8_STAGE(PG8_SA(0, 0), cA, voffA); PG8_STAGE(PG8_SA(0, 1), cA + hstepA, voffA);
  if (wr == 1) PG8_BAR;
  PG8_WAIT_V(2); PG8_BAR;
  PG8_STAGE(PG8_SB(1, 0), cB + kstep, voffB); PG8_STAGE(PG8_SA(1, 0), cA + kstep, voffA); PG8_STAGE(PG8_SB(1, 1), cB + hstepB + kstep, voffB);
  PG8_WAIT_V(6); PG8_BAR;
  for (;;) {
    const bool has_next = S.next(ui + 1, nxt);
    const char* nA = has_next ? nxt.a : cA; const char* nB = has_next ? nxt.b : cB;
    for (int t = 0; t < nt; t += 2) {
      const bool last = (t == nt - 2);
      const char* a1 = cA + (size_t)(t + 1) * kstep;
      const char* a2 = last ? nA : cA + (size_t)(t + 2) * kstep; const char* b2 = last ? nB : cB + (size_t)(t + 2) * kstep;
      const char* a3 = a2 + kstep; const char* b3 = b2 + kstep;
      PG8_LDB(B0, 0, 0); PG8_LDB(B1, 0, 1); PG8_SCHED; PG8_LDA(At, 0, 0); PG8_STAGE(PG8_SA(1, 1), a1 + hstepA, voffA);
      PG8_WAIT_V(8); PG8_WAIT_L(0); PG8_BAR; PG8_MMA(0, 0, At, B0); PG8_MMA(0, 1, At, B1); PG8_BAR; PG8_SCHED;
      PG8_LDA(At, 0, 1); PG8_STAGE(PG8_SB(0, 0), b2, voffB); PG8_STAGE(PG8_SB(0, 1), b2 + hstepB, voffB); PG8_STAGE(PG8_SA(0, 0), a2, voffA);
      PG8_WAIT_V(8); PG8_WAIT_L(0); PG8_BAR; PG8_MMA(1, 0, At, B0); PG8_MMA(1, 1, At, B1); PG8_BAR; PG8_SCHED;
      PG8_LDB(B0, 1, 0); PG8_LDB(B1, 1, 1); PG8_SCHED; PG8_LDA(At, 1, 0); PG8_STAGE(PG8_SA(0, 1), a2 + hstepA, voffA);
      PG8_WAIT_V(8); PG8_WAIT_L(0); PG8_BAR; PG8_MMA(0, 0, At, B0); PG8_MMA(0, 1, At, B1); PG8_BAR; PG8_SCHED;
      PG8_LDA(At, 1, 1); PG8_STAGE(PG8_SB(1, 0), b3, voffB); PG8_STAGE(PG8_SB(1, 1), b3 + hstepB, voffB); PG8_STAGE(PG8_SA(1, 0), a3, voffA);
      PG8_WAIT_V(8); PG8_WAIT_L(0); PG8_BAR; PG8_MMA(1, 0, At, B0); PG8_MMA(1, 1, At, B1); PG8_BAR; PG8_SCHED;
    }
    if (wr == 0) PG8_BAR;
    E(acc, cur, wr, wc, fr, fq);
    if (!has_next) break;
    bool carry = false;
    if constexpr (Epi::KEEPS) carry = E.keep(cur);
    if (!carry) {
#pragma unroll
    for (int a = 0; a < 2; ++a)
#pragma unroll
      for (int b = 0; b < 2; ++b)
#pragma unroll
        for (int m = 0; m < 4; ++m)
#pragma unroll
          for (int n = 0; n < 2; ++n) acc[a][b][m][n] = (f32x4){0.f, 0.f, 0.f, 0.f};
    }
    cur = nxt; cA = nA; cB = nB; ++ui;
    if (wr == 1) PG8_BAR;
  }
  PG8_WAIT_V(0);
  PG8_BAR;
#undef PG8_SA
#undef PG8_SB
#undef PG8_STAGE
#undef PG8_LDA
#undef PG8_LDB
#undef PG8_MMA
#undef PG8_WAIT_V
#undef PG8_WAIT_L
#undef PG8_BAR
#undef PG8_SCHED
}

template <class F> DI void epi_each(const f32x4 (&acc)[2][2][4][2], int wr, int wc, int fr, int fq, F f) {
  asm volatile("" : "+v"(fr), "+v"(fq));
#pragma unroll
  for (int ai = 0; ai < 2; ++ai)
#pragma unroll
    for (int m = 0; m < 4; ++m) { const int row = ai * HALF + wr * 64 + m * 16 + fr;
#pragma unroll
      for (int bj = 0; bj < 2; ++bj) { const int col = bj * HALF + wc * 32 + 8 * fq; f(row, col, acc[ai][bj][m][0], acc[ai][bj][m][1]); } }
}
template <int NB, class A, class L, class U>
DI void epi_batched(A& acc, int wr, int wc, int fr, int fq, L load, U use) {
  asm volatile("" : "+v"(fr), "+v"(fq));
#pragma unroll
  for (int b = 0; b < 16; b += NB) {
#pragma unroll
    for (int k = 0; k < NB; ++k) { const int idx = b + k, ai = idx >> 3, m = (idx >> 1) & 3, bj = idx & 1; load(k, ai * HALF + wr * 64 + m * 16 + fr, bj * HALF + wc * 32 + 8 * fq); }
    __builtin_amdgcn_sched_barrier(0);
#pragma unroll
    for (int k = 0; k < NB; ++k) { const int idx = b + k, ai = idx >> 3, m = (idx >> 1) & 3, bj = idx & 1; use(k, ai * HALF + wr * 64 + m * 16 + fr, bj * HALF + wc * 32 + 8 * fq, acc[ai][bj][m][0], acc[ai][bj][m][1]); }
    __builtin_amdgcn_sched_barrier(0);
  }
}
DI u32x4 pk8(const f32x4 a, const f32x4 b) { u32x4 w; w.x = cvt_pk(a[0], a[1]); w.y = cvt_pk(a[2], a[3]); w.z = cvt_pk(b[0], b[1]); w.w = cvt_pk(b[2], b[3]); return w; }

__host__ __device__ __forceinline__ bool g1a_perm_tile(int pn) { return pn < 10 || pn == 12 || pn == 13 || (pn >= 16 && pn <= 22); }
struct EpiG1a {
  static constexpr bool KEEPS = false;
  bf16_t* QBp; bf16_t* KVBp; const float* a_qn; const float* c_qn; const float* d_qn; const float* a_kn; const float* c_kn; const float* d_kn;
  DI void operator()(const f32x4 (&acc)[2][2][4][2], const Unit& u, int wr, int wc, int fr, int fq) const {
    bf16_t* base; int ld; const int pn = u.pn;
    if (pn < 12) { base = QBp + pn * BM; ld = PQ; } else { base = KVBp + (pn - 12) * BM; ld = PKV; }
    base += (size_t)u.pm * BM * ld;
    if (!g1a_perm_tile(pn)) {
      epi_each(acc, wr, wc, fr, fq, [&](int row, int col, const f32x4 v0, const f32x4 v1) { *(u32x4*)(base + (size_t)row * ld + col) = pk8(v0, v1); });
      return;
    }
    asm volatile("" : "+v"(fr), "+v"(fq));
    const float* gp; float post = 1.0f; bool norm = true;
    if (pn < 2) { gp = a_qn; post = 0.125f * LOG2E; } else if (pn < 4) { gp = c_qn; post = 0.125f * LOG2E; } else if (pn < 10) { gp = d_qn; post = 0.125f * LOG2E; }
    else if (pn < 14) gp = a_kn; else if (pn == 16) { gp = c_kn; norm = wc < 2; } else gp = d_kn;
    const f32x4 g00 = *(const f32x4*)(gp + 8 * fq), g01 = *(const f32x4*)(gp + 8 * fq + 4), g10 = *(const f32x4*)(gp + 32 + 8 * fq), g11 = *(const f32x4*)(gp + 32 + 8 * fq + 4);
#pragma unroll
    for (int ai = 0; ai < 2; ++ai)
#pragma unroll
      for (int m = 0; m < 4; ++m) {
        const int row = ai * HALF + wr * 64 + m * 16 + fr;
        f32x4 v00 = acc[ai][0][m][0], v01 = acc[ai][0][m][1], v10 = acc[ai][1][m][0], v11 = acc[ai][1][m][1];
        float ss = 0.f;
#pragma unroll
        for (int j = 0; j < 4; ++j) ss += v00[j] * v00[j] + v01[j] * v01[j] + v10[j] * v10[j] + v11[j] * v11[j];
        ss += __shfl_xor(ss, 16); ss += __shfl_xor(ss, 32);
        if (norm) { const float r = rsqrtf(ss * (1.0f / 64.0f) + EPS) * post; v00 = v00 * r * g00; v01 = v01 * r * g01; v10 = v10 * r * g10; v11 = v11 * r * g11; }
        bf16_t* p = base + (size_t)row * ld + wc * 64 + 8 * fq;
        *(u32x4*)p = pk8(v00, v01); *(u32x4*)(p + 32) = pk8(v10, v11);
      }
  }
};
struct EpiPlain {
  static constexpr bool KEEPS = false;
  bf16_t* C; int ldc;
  DI void operator()(const f32x4 (&acc)[2][2][4][2], const Unit& u, int wr, int wc, int fr, int fq) const {
    bf16_t* base = C + (size_t)u.pm * BM * ldc + u.pn * BM;
    epi_each(acc, wr, wc, fr, fq, [&](int row, int col, const f32x4 v0, const f32x4 v1) { *(u32x4*)(base + (size_t)row * ldc + col) = pk8(v0, v1); });
  }
};
struct EpiGate {
  static constexpr bool KEEPS = false;
  bf16_t* C; const float* bias;
  DI void operator()(const f32x4 (&acc)[2][2][4][2], const Unit& u, int wr, int wc, int fr, int fq) const {
    bf16_t* base = C + (size_t)u.pm * BM * PGATE + u.pn * BM; const float* bb = bias + u.pn * BM + wc * 32 + 8 * fq;
    f32x4 bv[2][2];
#pragma unroll
    for (int bj = 0; bj < 2; ++bj) { bv[bj][0] = *(const f32x4*)(bb + bj * HALF); bv[bj][1] = *(const f32x4*)(bb + bj * HALF + 4); }
    epi_batched<8>(acc, wr, wc, fr, fq, [&](int, int, int) {}, [&](int k, int row, int col, f32x4 v0, f32x4 v1) {
      const f32x4 b0 = bv[k & 1][0], b1 = bv[k & 1][1];
#pragma unroll
      for (int j = 0; j < 4; ++j) { v0[j] = sigmoidf_(v0[j] + b0[j]); v1[j] = sigmoidf_(v1[j] + b1[j]); }
      *(u32x4*)(base + (size_t)row * PGATE + col) = pk8(v0, v1); });
  }
};
struct EpiZ {
  static constexpr bool KEEPS = false;
  bf16_t* QBp;
  DI void operator()(const f32x4 (&acc)[2][2][4][2], const Unit& u, int wr, int wc, int fr, int fq) const {
    const int br = u.pn >> 1; const int ocol = (br == 0 ? QC_OA : br == 1 ? QC_OB : br == 2 ? QC_CQ : br == 3 ? QC_DQ : QC_MQ) + (u.pn & 1) * BM;
    bf16_t* base = QBp + (size_t)u.pm * BM * PQ + ocol;
    u32x4 ob[8];
    epi_batched<8>(acc, wr, wc, fr, fq, [&](int k, int row, int col) { ob[k] = *(const u32x4*)(base + (size_t)row * PQ + col); },
      [&](int k, int row, int col, f32x4 v0, f32x4 v1) {
        float o[8]; unpack8(ob[k], o);
#pragma unroll
        for (int j = 0; j < 4; ++j) { v0[j] = o[j] * v0[j] * sigmoidf_(v0[j]); v1[j] = o[4 + j] * v1[j] * sigmoidf_(v1[j]); }
        *(u32x4*)(base + (size_t)row * PQ + col) = pk8(v0, v1); });
  }
};
struct EpiMerge {
  static constexpr bool KEEPS = true;
  bf16_t* ACC; const bf16_t* GATEp; int bmask;
  DI bool keep(const Unit& u) const { return u.aux < 4; }
  DI void operator()(f32x4 (&acc)[2][2][4][2], const Unit& u, int wr, int wc, int fr, int fq) const {
    const int br = u.aux;
    bf16_t* base = ACC + (size_t)u.pm * BM * DM + u.pn * BM; const bf16_t* gb = GATEp + (size_t)u.pm * BM * PGATE + br * 1024 + u.pn * BM;
    u32x4 ga[4], gn[4];
    if (br < 4) {
      epi_batched<4>(acc, wr, wc, fr, fq, [&](int k, int row, int col) { ga[k] = *(const u32x4*)(gb + (size_t)row * PGATE + col); gn[k] = *(const u32x4*)(gb + 1024 + (size_t)row * PGATE + col); },
        [&](int k, int, int, f32x4& v0, f32x4& v1) {
          float g0[8], g1[8]; unpack8(ga[k], g0); unpack8(gn[k], g1);
#pragma unroll
          for (int j = 0; j < 4; ++j) { v0[j] *= g0[j] * __builtin_amdgcn_rcpf(fmaxf(g1[j], 1e-20f)); v1[j] *= g0[4 + j] * __builtin_amdgcn_rcpf(fmaxf(g1[4 + j], 1e-20f)); } });
    } else {
      epi_batched<4>(acc, wr, wc, fr, fq, [&](int k, int row, int col) { ga[k] = *(const u32x4*)(gb + (size_t)row * PGATE + col); },
        [&](int k, int row, int col, f32x4& a0, f32x4& a1) {
          float g0[8]; unpack8(ga[k], g0); f32x4 v0 = a0, v1 = a1;
#pragma unroll
          for (int j = 0; j < 4; ++j) { v0[j] *= g0[j]; v1[j] *= g0[4 + j]; }
          *(u32x4*)(base + (size_t)row * DM + col) = pk8(v0, v1); });
    }
  }
};
struct EpiOut {
  static constexpr bool KEEPS = false;
  const float* X; float* Y;
  DI void operator()(const f32x4 (&acc)[2][2][4][2], const Unit& u, int wr, int wc, int fr, int fq) const {
    const size_t off = (size_t)u.pm * BM * DM + u.pn * BM;
    f32x4 xa[4], xb[4];
    epi_batched<4>(acc, wr, wc, fr, fq, [&](int k, int row, int col) { const size_t o = off + (size_t)row * DM + col; xa[k] = *(const f32x4*)(X + o); xb[k] = *(const f32x4*)(X + o + 4); },
      [&](int k, int row, int col, const f32x4 v0, const f32x4 v1) { const size_t o = off + (size_t)row * DM + col; *(f32x4*)(Y + o) = xa[k] + v0; *(f32x4*)(Y + o + 4) = xb[k] + v1; });
  }
};
}

DI void grid_sync() {
  __builtin_amdgcn_fence(__ATOMIC_RELEASE, "agent");
  asm volatile("s_waitcnt vmcnt(0)" ::: "memory");
  cg::this_grid().sync();
  __builtin_amdgcn_fence(__ATOMIC_ACQUIRE, "agent");
  asm volatile("s_waitcnt vmcnt(0)" ::: "memory");
}

#define XB_TMO      128
#define XB_XCNT(j)  (256  + 64 * (j))
#define XB_XSUB(j)  (1280 + 64 * (j))
#define XB_XGEN(j)  (2304 + 64 * (j))
#define XB_TOP      3328
#define XB_TOPGEN   3392
#define XCD_BAR_WORDS 3456
#define XB_SPIN_CAP (1u << 22)
DI unsigned xb_ld(unsigned* p)              { return __hip_atomic_load(p, __ATOMIC_RELAXED, __HIP_MEMORY_SCOPE_AGENT); }
DI unsigned xb_add(unsigned* p, unsigned v) { return __hip_atomic_fetch_add(p, v, __ATOMIC_RELAXED, __HIP_MEMORY_SCOPE_AGENT); }
DI unsigned xb_xcc_id() { return (unsigned)__builtin_amdgcn_s_getreg((3 << 11) | 20) & 0xFu; }
#define XB_SPIN(cond, bar) do { unsigned _sp = 0; while (cond) { __builtin_amdgcn_s_sleep(1); \
    if ((++_sp & 255u) == 0u) { if (xb_ld(&(bar)[XB_TMO])) break; if (_sp > XB_SPIN_CAP) { atomicAdd(&(bar)[XB_TMO], 1u); break; } } } } while (0)
struct XcdBarrier { unsigned* bar; unsigned x; volatile LAS unsigned* st; };
DI XcdBarrier xcd_barrier_post(unsigned* bar, volatile LAS unsigned* st) {
  XcdBarrier b; b.bar = bar; b.x = xb_xcc_id(); b.st = st;
  if (threadIdx.x == 0) (void)xb_add(&bar[XB_XCNT(b.x)], 1u);
  return b;
}
DI void xcd_barrier_complete(unsigned* bar, unsigned x, unsigned& nloc, unsigned& nx) {
  const unsigned G = gridDim.x * gridDim.y * gridDim.z;
  unsigned sum, cnt, mine, sp = 0u;
  for (;;) {
    sum = 0u; cnt = 0u; mine = 0u;
#pragma unroll
    for (unsigned j = 0; j < 16; ++j) { const unsigned c = xb_ld(&bar[XB_XCNT(j)]); sum += c; cnt += (c > 0u) ? 1u : 0u; mine = (j == x) ? c : mine; }
    if (sum == G) break;
    __builtin_amdgcn_s_sleep(1);
    if ((++sp & 255u) == 0u) { if (xb_ld(&bar[XB_TMO])) break; if (sp > XB_SPIN_CAP) { atomicAdd(&bar[XB_TMO], 1u); break; } }
  }
  nloc = mine > 0u ? mine : 1u; nx = cnt > 0u ? cnt : 1u;
}
DI void xcd_barrier(const XcdBarrier& b) {
  asm volatile("s_waitcnt vmcnt(0)" ::: "memory");
  __syncthreads();
  if (threadIdx.x == 0) {
    unsigned* bar = b.bar;
    __builtin_amdgcn_s_waitcnt(0);
    unsigned nloc = b.st[0], nx = b.st[1];
    if (nloc == 0u) { xcd_barrier_complete(bar, b.x, nloc, nx); b.st[0] = nloc; b.st[1] = nx; }
    const unsigned old = xb_add(&bar[XB_XSUB(b.x)], 1u);
    const unsigned gen = old / nloc;
    if (old + 1u == (gen + 1u) * nloc) {
      __builtin_amdgcn_fence(__ATOMIC_RELEASE, "agent");
      asm volatile("s_waitcnt vmcnt(0)" ::: "memory");
      const unsigned og = xb_add(&bar[XB_TOP], 1u);
      const unsigned tg = og / nx;
      if (og + 1u == (tg + 1u) * nx) xb_add(&bar[XB_TOPGEN], 1u);
      else XB_SPIN(xb_ld(&bar[XB_TOPGEN]) == tg, bar);
      __builtin_amdgcn_fence(__ATOMIC_ACQUIRE, "agent");
      xb_add(&bar[XB_XGEN(b.x)], 1u);
      asm volatile("s_waitcnt vmcnt(0)" ::: "memory");
    } else {
      XB_SPIN(xb_ld(&bar[XB_XGEN(b.x)]) == gen, bar);
      __builtin_amdgcn_fence(__ATOMIC_ACQUIRE, "agent");
      asm volatile("s_waitcnt vmcnt(0)" ::: "memory");
    }
  }
  __syncthreads();
}
template <class F>
DI void tconv(LAS float* tile, bf16_t* dst, int ldd, int Nd, int K, F f, int cu, int ncu) {
  int tid = threadIdx.x; asm volatile("" : "+v"(tid)); const int ntk = K / 64, ntot = (Nd / 64) * ntk;
  for (int t = cu; t < ntot; t += ncu) {
    const int n0 = (t / ntk) * 64, k0 = (t % ntk) * 64;
#pragma unroll
    for (int i = 0; i < 8; ++i) { const int e = tid + i * 512, kk = e >> 6, nn = e & 63; tile[kk * 65 + nn] = f(k0 + kk, n0 + nn); }
    __syncthreads();
    { const int n = tid >> 3, kc = (tid & 7) * 8; float v[8];
#pragma unroll
      for (int j = 0; j < 8; ++j) v[j] = tile[(kc + j) * 65 + n];
      *(u32x4*)(dst + (size_t)(n0 + n) * ldd + k0 + kc) = pack8(v); }
    __syncthreads();
  }
}
DI int win_src(int n) {
  if (n < NG1 && pg8::g1a_perm_tile(n >> 8)) { const int ct = n & 255; n = (n & ~255) + ((ct >> 5) & 3) * 64 + (ct >> 7) * 32 + (ct & 31); }
  if (n < 3072) { if (n < 512) return n; if (n < 1024) return 1952 + (n - 512); if (n < 2560) return 2720 + (n - 1024); return 7328 + (n - 2560); }
  if (n < NG1) { const int c = n - 3072;
    if (c < 512) return 512 + c; if (c < 1024) return 1024 + (c - 512); if (c < 1152) return 2464 + (c - 1024); if (c < 1280) return 2592 + (c - 1152);
    if (c < 2816) return 4256 + (c - 1280); if (c < 4352) return 5792 + (c - 2816); if (c < 4608) return 1536 + (c - 4352); if (c < 4736) return 1792 + (c - 4608);
    if (c < 4768) return 1920 + (c - 4736); return -1; }
  return 7840 + (n - NG1);
}

DI u32x4 ldraw(const bf16_t* src, bool act) { u32x4 raw = (u32x4){0u, 0u, 0u, 0u}; if (act) raw = *(const u32x4*)src; return raw; }
template <int LPH>
DI void seg_norm(const bf16_t* src, bf16_t* dst, bool act, const float* gain, float post, float* vout, const u32x4* pre = nullptr, float inscale = 1.0f) {
  float v[8]; u32x4 raw; if (pre) raw = *pre; else raw = ldraw(src, act); unpack8(raw, v);
#pragma unroll
  for (int i = 0; i < 8; ++i) v[i] *= inscale;
  float ss = 0.f;
#pragma unroll
  for (int i = 0; i < 8; ++i) ss += v[i] * v[i];
#pragma unroll
  for (int o = 1; o < LPH; o <<= 1) ss += __shfl_xor(ss, o);
  const float r = rsqrtf(ss * (1.0f / (LPH * 8)) + EPS) * post;
#pragma unroll
  for (int i = 0; i < 8; ++i) v[i] = v[i] * r * (act ? gain[i] : 0.f);
  if (vout) {
#pragma unroll
    for (int i = 0; i < 8; ++i) vout[i] = v[i];
  } else if (act) *(u32x4*)dst = pack8(v);
}
DI void rope4(float* v, int lane4, const float* cs  , const float* sn  ) {
  const int jb = (lane4 & 1) * 8;
#pragma unroll
  for (int i = 0; i < 8; ++i) {
    const float partner = __shfl_xor(v[i], 2);
    const float c = cs[jb + i], s = sn[jb + i];
    v[i] = (lane4 < 2) ? (v[i] * c - partner * s) : (v[i] * c + partner * s);
  }
}


#define AT_SB __builtin_amdgcn_sched_barrier(0)
template <int NS, int KP>
DI void attn_qk(f32x16 (&st)[2], const bf16x8 (&qf)[NS], const LAS unsigned char* kbl  ) {
#pragma unroll
  for (int i = 0; i < 16; ++i) { st[0][i] = 0.f; st[1][i] = 0.f; }
  bf16x8 a0 = *(const LAS bf16x8*)(kbl), a1 = *(const LAS bf16x8*)(kbl + 32 * KP);
#pragma unroll
  for (int s = 0; s < NS; ++s) {
    bf16x8 n0 = a0, n1 = a1;
    if (s + 1 < NS) { n0 = *(const LAS bf16x8*)(kbl + 32 * (s + 1)); n1 = *(const LAS bf16x8*)(kbl + 32 * KP + 32 * (s + 1)); }
    AT_SB;
    st[0] = __builtin_amdgcn_mfma_f32_32x32x16_bf16(a0, qf[s], st[0], 0, 0, 0);
    st[1] = __builtin_amdgcn_mfma_f32_32x32x16_bf16(a1, qf[s], st[1], 0, 0, 0);
    AT_SB;
    a0 = n0; a1 = n1;
  }
}
template <int NDV, int VP>
DI void attn_pv_load0(s16x4 (&l0)[NDV], s16x4 (&h0)[NDV], LAS unsigned char* vbl) {
#pragma unroll
  for (int d = 0; d < NDV; ++d) {
    l0[d] = __builtin_bit_cast(s16x4, __builtin_amdgcn_ds_read_tr16_b64_v4i16((LAS s16x4*)(vbl + d * 64)));
    h0[d] = __builtin_bit_cast(s16x4, __builtin_amdgcn_ds_read_tr16_b64_v4i16((LAS s16x4*)(vbl + 8 * VP + d * 64))); }
}
template <int NDV, int VP, bool PRE>
DI void attn_pv(f32x16 (&o)[NDV], const u32x4 (&pfw)[4], LAS unsigned char* vbl  , s16x4 (&l0)[NDV], s16x4 (&h0)[NDV]) {
  s16x4 l1[NDV], h1[NDV];
#define AT_LD(l, h, b) _Pragma("unroll") for (int d = 0; d < NDV; ++d) { \
    l[d] = __builtin_bit_cast(s16x4, __builtin_amdgcn_ds_read_tr16_b64_v4i16((LAS s16x4*)(vbl + (16 * (b)) * VP + d * 64))); \
    h[d] = __builtin_bit_cast(s16x4, __builtin_amdgcn_ds_read_tr16_b64_v4i16((LAS s16x4*)(vbl + (16 * (b) + 8) * VP + d * 64))); }
#define AT_MM(l, h, b) { const bf16x8 _pf = __builtin_bit_cast(bf16x8, pfw[b]); _Pragma("unroll") for (int d = 0; d < NDV; ++d) \
    o[d] = __builtin_amdgcn_mfma_f32_32x32x16_bf16(__builtin_shufflevector(l[d], h[d], 0, 1, 2, 3, 4, 5, 6, 7), _pf, o[d], 0, 0, 0); }
  if (!PRE) { AT_LD(l0, h0, 0); }
  AT_LD(l1, h1, 1); AT_SB; AT_MM(l0, h0, 0); AT_SB;
  AT_LD(l0, h0, 2); AT_SB; AT_MM(l1, h1, 1); AT_SB;
  AT_LD(l1, h1, 3); AT_SB; AT_MM(l0, h0, 2); AT_SB;
  AT_MM(l1, h1, 3); AT_SB;
#undef AT_LD
#undef AT_MM
}
template <int DQK, int DV, bool BIAS, bool MASK, bool BMM>
DI void attn_item(LAS unsigned char* lds, const bf16_t* Q, int pq, const bf16_t* K, int pk, const bf16_t* V, int pv, bf16_t* O, int po,
                  float* lse, int lse_stride, int q0, int L, int W, float slope2, float m_init, float l_init) {
  constexpr int KP = DQK * 2 + 16, VP = DV * 2 + 64, KBYTES = 64 * KP, VBYTES = 64 * VP, BUF = KBYTES + VBYTES;
  constexpr int KC8 = DQK / 8, VC8 = DV / 8, KCH = 64 * KC8, VCH = 64 * VC8, KPT = (KCH + 511) / 512, VPT = (VCH + 511) / 512;
  constexpr int NS = DQK / 16, NDV = DV / 32;
  int tid = threadIdx.x; asm volatile("" : "+v"(tid));
  const int wid = tid >> 6, lane = tid & 63, r = lane & 31, h = lane >> 5;
  const int qw0 = q0 + 32 * wid, qi = qw0 + r;
  bf16x8 qf[NS];
#pragma unroll
  for (int s = 0; s < NS; ++s) qf[s] = *(const bf16x8*)(Q + (size_t)qi * pq + 16 * s + 8 * h);
  f32x16 o[NDV];
#pragma unroll
  for (int d = 0; d < NDV; ++d)
#pragma unroll
    for (int i = 0; i < 16; ++i) o[d][i] = 0.f;
  float m = m_init, lsum = (h == 0) ? l_init : 0.f;
  u32x4 kext[2]; unsigned cw1 = 0u, cw2 = 0u;
  if (BMM) {
    const unsigned one = 0x3F80u;
#pragma unroll
    for (int b2 = 0; b2 < 2; ++b2) { const unsigned jb = cvt_pk((float)(32 * b2 + r), 0.f) & 0xffffu;
      kext[b2] = (h == 0) ? (u32x4){one | (one << 16), one | (jb << 16), jb | (jb << 16), 0u} : (u32x4){0u, 0u, 0u, 0u}; }
    const unsigned c_hi = cvt_pk(slope2, 0.f) & 0xffffu; const float r1 = slope2 - __uint_as_float(c_hi << 16);
    const unsigned c_mid = cvt_pk(r1, 0.f) & 0xffffu; const float r2 = r1 - __uint_as_float(c_mid << 16); const unsigned c_lo = cvt_pk(r2, 0.f) & 0xffffu;
    cw1 = c_hi << 16; cw2 = c_mid | (c_lo << 16);
  }
  const int klo = (q0 - W > 0 ? q0 - W : 0) >> 6;
  const int khi = ((q0 + 256 + W < L ? q0 + 256 + W : L) + 63) >> 6;
  const int nt = khi - klo;
  u32x4 kreg[KPT], vreg[VPT];
#define AT_GLOAD(kt) do { const int _k0 = (kt) * 64; \
    _Pragma("unroll") for (int _i = 0; _i < KPT; ++_i) { const int _c = tid + _i * 512; if (_c < KCH) { const int _row = _c / KC8, _cc = _c - _row * KC8; kreg[_i] = *(const u32x4*)(K + (size_t)(_k0 + _row) * pk + _cc * 8); } } \
    _Pragma("unroll") for (int _i = 0; _i < VPT; ++_i) { const int _c = tid + _i * 512; if (_c < VCH) { const int _row = _c / VC8, _cc = _c - _row * VC8; vreg[_i] = *(const u32x4*)(V + (size_t)(_k0 + _row) * pv + _cc * 8); } } } while (0)
#define AT_LSTORE(ks, vs_) do { LAS unsigned char* _kb = lds + (ks) * KBYTES; LAS unsigned char* _vb = lds + 2 * KBYTES + (vs_) * VBYTES; \
    _Pragma("unroll") for (int _i = 0; _i < KPT; ++_i) { const int _c = tid + _i * 512; if (_c < KCH) { const int _row = _c / KC8, _cc = _c - _row * KC8; *(LAS u32x4*)(_kb + _row * KP + _cc * 16) = kreg[_i]; } } \
    _Pragma("unroll") for (int _i = 0; _i < VPT; ++_i) { const int _c = tid + _i * 512; if (_c < VCH) { const int _row = _c / VC8, _cc = _c - _row * VC8; *(LAS u32x4*)(_vb + _row * VP + _cc * 16) = vreg[_i]; } } } while (0)
#define AT_PV(vstage) do { s16x4 _l0[NDV], _h0[NDV]; attn_pv<NDV, VP, false>(o, pfw, lds + 2 * KBYTES + (vstage) * VBYTES + vlane_off, _l0, _h0); } while (0)
  AT_GLOAD(klo); AT_LSTORE(0, 0); __syncthreads();
  const int i16 = lane & 15, q4 = i16 >> 2, p4 = i16 & 3, blk = (lane >> 4) & 1;
  const int vlane_off = (4 * h + q4) * VP + (16 * blk + 4 * p4) * 2;
  const bool lag = wid >= 4;
  u32x4 pfw[4]; bool pend = false; int pend_vs = 0, vs = 0;
#pragma unroll
  for (int i = 0; i < 4; ++i) pfw[i] = (u32x4){0u, 0u, 0u, 0u};
  for (int t = 0; t < nt; ++t) {
    const int k0 = (klo + t) * 64;
    if (t + 1 < nt) AT_GLOAD(klo + t + 1);
    const bool active = (k0 + 63 >= qw0 - W) && (k0 <= qw0 + 31 + W);
    if (pend) { AT_PV(pend_vs); pend = false; }
    if (active) {
      LAS unsigned char* kb = lds + (t & 1) * KBYTES;
      f32x16 st[2];
      attn_qk<NS, KP>(st, qf, kb + r * KP + 16 * h);
      const int side = !BMM ? 0 : (k0 + 63 < qw0) ? 1 : (k0 > qw0 + 31) ? -1 : 0;
      if (BMM && side != 0) {
        const float av = (side > 0 ? -slope2 : slope2) * (float)(qi - k0);
        const unsigned a_hi = cvt_pk(av, 0.f) & 0xffffu; const float q1 = av - __uint_as_float(a_hi << 16);
        const unsigned a_mid = cvt_pk(q1, 0.f) & 0xffffu; const float q2 = q1 - __uint_as_float(a_mid << 16); const unsigned a_lo = cvt_pk(q2, 0.f) & 0xffffu;
        const unsigned sg = side > 0 ? 0u : 0x80008000u;
        const u32x4 qe = {a_hi | (a_mid << 16), a_lo | ((cw1 ^ sg) & 0xffff0000u), cw2 ^ sg, 0u};
        const bf16x8 qeb = __builtin_bit_cast(bf16x8, qe);
        st[0] = __builtin_amdgcn_mfma_f32_32x32x16_bf16(__builtin_bit_cast(bf16x8, kext[0]), qeb, st[0], 0, 0, 0);
        st[1] = __builtin_amdgcn_mfma_f32_32x32x16_bf16(__builtin_bit_cast(bf16x8, kext[1]), qeb, st[1], 0, 0, 0);
      }
      s16x4 vl0[NDV], vh0[NDV];
      if (!lag) attn_pv_load0<NDV, VP>(vl0, vh0, lds + 2 * KBYTES + vs * VBYTES + vlane_off);
      if ((BIAS || MASK) && !(BMM && side != 0)) {
        const float basef = (float)(qi - k0 - 4 * h), Wf = (float)W;
#pragma unroll
        for (int b2 = 0; b2 < 2; ++b2)
#pragma unroll
          for (int i = 0; i < 16; ++i) {
            float s = st[b2][i];
            const float df = basef - (float)(32 * b2 + (i & 3) + 8 * (i >> 2));
            if (BIAS) s = s - slope2 * fabsf(df);
            if (MASK) s = (fabsf(df) > Wf) ? -INFINITY : s;
            st[b2][i] = s; }
      }
      float ps = 0.f;
#pragma unroll
      for (int b2 = 0; b2 < 2; ++b2)
#pragma unroll
        for (int i = 0; i < 16; ++i) { const float p = fexp2(st[b2][i]); st[b2][i] = p; ps += p; }
      lsum += ps;
#pragma unroll
      for (int b2 = 0; b2 < 2; ++b2)
#pragma unroll
        for (int s2 = 0; s2 < 2; ++s2) {
          u32x4 pw; pw.x = cvt_pk(st[b2][8 * s2 + 0], st[b2][8 * s2 + 1]); pw.y = cvt_pk(st[b2][8 * s2 + 2], st[b2][8 * s2 + 3]);
          pw.z = cvt_pk(st[b2][8 * s2 + 4], st[b2][8 * s2 + 5]); pw.w = cvt_pk(st[b2][8 * s2 + 6], st[b2][8 * s2 + 7]);
          pfw[b2 * 2 + s2] = pw;
        }
      if (lag) { pend = true; pend_vs = vs; } else { attn_pv<NDV, VP, true>(o, pfw, lds + 2 * KBYTES + vs * VBYTES + vlane_off, vl0, vh0); }
    }
    const int vsn = vs == 2 ? 0 : vs + 1;
    if (t + 1 < nt) AT_LSTORE((t + 1) & 1, vsn);
    __syncthreads();
    vs = vsn;
  }
  if (pend) { AT_PV(pend_vs); }
#undef AT_PV
#undef AT_GLOAD
#undef AT_LSTORE
  const float lt = lsum + __shfl_xor(lsum, 32); const float inv = 1.0f / lt;
#pragma unroll
  for (int d = 0; d < NDV; ++d)
#pragma unroll
    for (int g4 = 0; g4 < 4; ++g4) {
      u32x2 w; w.x = cvt_pk(o[d][4 * g4] * inv, o[d][4 * g4 + 1] * inv); w.y = cvt_pk(o[d][4 * g4 + 2] * inv, o[d][4 * g4 + 3] * inv);
      *(u32x2*)(O + (size_t)qi * po + 32 * d + 8 * g4 + 4 * h) = w;
    }
  if (lse != nullptr && h == 0) lse[(size_t)qi * lse_stride] = m + __log2f(lt);
}


#ifdef DBG
#define WS_DBG (512 * 1024)
DI void dbg_max(unsigned* p, float e) { if (!(e >= 0.f)) e = 1e9f; atomicMax(p, __float_as_uint(e)); }
DI unsigned dbg_hash(unsigned x) { x ^= x >> 16; x *= 0x7feb352du; x ^= x >> 15; x *= 0x846ca68bu; x ^= x >> 16; return x; }
template <int DQK, int DV>
DI float dbg_attn_row(LAS float* sc, const bf16_t* Q, int pq, const bf16_t* K, int pk, const bf16_t* V, int pv, const bf16_t* O, int po,
                      int qi, int L, int W, float slope2, float m_init, float l_init, int lane) {
  float mx = m_init;
  for (int j = lane; j < L; j += 64) {
    int d = qi - j; d = d < 0 ? -d : d; float s = -INFINITY;
    if (d <= W) { s = 0.f; for (int c = 0; c < DQK; ++c) s += bf2f(Q[(size_t)qi * pq + c]) * bf2f(K[(size_t)j * pk + c]); s -= slope2 * (float)d; }
    sc[j] = s; mx = fmaxf(mx, s);
  }
  for (int o = 1; o < 64; o <<= 1) mx = fmaxf(mx, __shfl_xor(mx, o));
  float sum = 0.f;
  for (int j = lane; j < L; j += 64) { const float p = exp2f(sc[j] - mx); sc[j] = p; sum += p; }
  for (int o = 1; o < 64; o <<= 1) sum += __shfl_xor(sum, o);
  sum += l_init * exp2f(m_init - mx);
  float emax = 0.f, rmax = 0.f;
  for (int dv = lane; dv < DV; dv += 64) {
    float acc = 0.f; for (int j = 0; j < L; ++j) acc += sc[j] * bf2f(V[(size_t)j * pv + dv]);
    acc /= sum; const float got = bf2f(O[(size_t)qi * po + dv]);
    emax = fmaxf(emax, fabsf(got - acc)); rmax = fmaxf(rmax, fabsf(acc));
  }
  for (int o = 1; o < 64; o <<= 1) { emax = fmaxf(emax, __shfl_xor(emax, o)); rmax = fmaxf(rmax, __shfl_xor(rmax, o)); }
  return emax / (rmax + 1e-3f);
}
#endif
#define WSP(T, off) ((T*)(ap->ws + (off)))
#define ROPE WSP(float, WS_ROPE)
#define WIN WSP(bf16_t, WS_WIN)
#define WMLA WSP(bf16_t, WS_WMLA)
#define WMEM WSP(bf16_t, WS_WMEM)
#define WBR WSP(bf16_t, WS_WBR)
#define WOUT WSP(bf16_t, WS_WOUT)
#define MN WSP(bf16_t, WS_MN)
#define MKV WSP(bf16_t, WS_MKV)
#define LSE WSP(float, WS_LSE)
#define H WSP(bf16_t, WS_H)
#define QB WSP(bf16_t, WS_QB)
#define KVB WSP(bf16_t, WS_KVB)
#define MLA WSP(bf16_t, WS_MLA)
#define BK WSP(bf16_t, WS_BK)
#define GATE WSP(bf16_t, WS_GATE)
typedef const __attribute__((address_space(4))) Args* CArgsP;
__global__ void __launch_bounds__(512, 2) mega(Args args_unused) {
  extern __shared__ __attribute__((aligned(16))) unsigned char shm_raw[];
  LAS unsigned char* lds = (LAS unsigned char*)shm_raw;
  const int ph_lo = ((CArgsP)__builtin_amdgcn_kernarg_segment_ptr())->ph_lo, ph_hi = ((CArgsP)__builtin_amdgcn_kernarg_segment_ptr())->ph_hi;
  volatile LAS unsigned* xb_st = (volatile LAS unsigned*)(lds + 131072);
  if (threadIdx.x == 0) { xb_st[0] = 0u; xb_st[1] = 0u; }
  __syncthreads();
  const XcdBarrier xbar = xcd_barrier_post((unsigned*)(((CArgsP)__builtin_amdgcn_kernarg_segment_ptr())->ws), xb_st);
  for (int ph = ph_lo; ph < ph_hi; ++ph) {
    CArgsP ap0 = (CArgsP)__builtin_amdgcn_kernarg_segment_ptr(); int phv = ph;
    asm volatile("" : "+s"(ap0), "+s"(phv));
#define PHASE_AP CArgsP ap = ap0; asm volatile("" : "+s"(ap));
    int tid = threadIdx.x; asm volatile("" : "+v"(tid));
    const int wid = tid >> 6, lane = tid & 63;
    int G = gridDim.x, cu = blockIdx.x; asm volatile("" : "+s"(G), "+s"(cu));
    const int l = phv / 31, idx = phv % 31;
    if (idx >= 1 && (idx - 1) % 10 == 2) continue;
    if (idx == 0) {
      PHASE_AP
      LAS float* tile = (LAS float*)lds;
      const int dmask = ap->pad;
      if (dmask & 1) { const float* w = ap->in[5] + (size_t)l * DM * NIN;
        tconv(tile, WIN, DM, NWIN, DM, [&](int k, int n) { const int c = win_src(n); return c < 0 ? 0.f : w[(size_t)k * NIN + c]; }, cu, G); }
      if (dmask & 2) { const float* gcq = ap->in[10] + l * 256; const float* gckv = ap->in[11] + l * 128;
        const float* wq = ap->in[12] + (size_t)l * 256 * 384; const float* wk = ap->in[13] + (size_t)l * 128 * 768;
        tconv(tile, WMLA, 384, PMLA, 384, [&](int k, int n) { if (n < 384) return k < 256 ? wq[k * 384 + n] * gcq[k] : 0.f; if (n < 1152) return k >= 256 ? wk[(k - 256) * 768 + (n - 384)] * gckv[k - 256] : 0.f; return 0.f; }, cu, G); }
      if (dmask & 4) { const float* w = ap->in[22] + (size_t)l * DM * 1024;
        tconv(tile, WMEM, DM, 1024, DM, [&](int k, int n) { return w[(size_t)k * 1024 + n]; }, cu, G); }
      if (dmask & 8) { const float* w = ap->in[26] + (size_t)l * 5 * 512 * 1024;
        tconv(tile, WBR, 512, 5120, 512, [&](int k, int n) { return w[((size_t)(n >> 10) * 512 + k) * 1024 + (n & 1023)]; }, cu, G); }
      if (dmask & 16) { const float* w = ap->in[27] + (size_t)l * DM * DM;
        tconv(tile, WOUT, DM, DM, DM, [&](int k, int n) { return w[(size_t)k * DM + n]; }, cu, G); }
      if (l == 0) {
        const float invf[16] = {1.0f, 0.5623413251903491f, 0.31622776601683794f, 0.1778279410038923f, 0.1f, 0.05623413251903491f, 0.03162277660168379f, 0.01778279410038923f,
                                0.01f, 0.005623413251903491f, 0.0031622776601683794f, 0.001778279410038923f, 0.001f, 0.0005623413251903491f, 0.00031622776601683794f, 0.0001778279410038923f};
        for (int e = cu * 512 + tid; e < 8192 * 16; e += G * 512) {
          const int pos = e >> 4, j = e & 15; float iv = invf[0];
#pragma unroll
          for (int q = 1; q < 16; ++q) iv = (j == q) ? invf[q] : iv;
          const float ang = (float)pos * iv;
          const double rev = (double)ang * 0.15915494309189535; const float fr = (float)(rev - __builtin_rint(rev));
          ROPE[pos * 32 + j] = __builtin_amdgcn_cosf(fr); ROPE[pos * 32 + 16 + j] = __builtin_amdgcn_sinf(fr);
        }
      }
    } else {
      const int u = (idx - 1) / 10, p = (idx - 1) % 10;
      const int S = (u == 0) ? 4096 : 8192, nseq = (u == 0) ? 4 : 2, nmem = nseq * 256;
#define XIN ((l == 0) ? ((u == 0) ? ap->in[0] : ap->in[1] + (size_t)(u - 1) * TU * DM) : ap->out + (size_t)u * TU * DM)
#define XOUT (ap->out + (size_t)u * TU * DM)
#define MEMIN ((u == 0) ? ap->in[2] : ap->in[3] + (size_t)(u - 1) * 512 * DM)
      if (p == 0) {
        PHASE_AP
        const float* xin = XIN; const float* memin = MEMIN;
        const float* g1 = ap->in[4] + l * DM; const float* g2 = ap->in[21] + l * DM;
        for (int row = cu * 8 + wid; row < TU + nmem; row += G * 8) {
          const bool ism = row >= TU; const float* src = ism ? memin + (size_t)(row - TU) * DM : xin + (size_t)row * DM;
          const float* gg = ism ? g2 : g1; bf16_t* dst = ism ? MN + (size_t)(row - TU) * DM : H + (size_t)row * DM;
          f32x4 v[4]; float ss = 0.f;
#pragma unroll
          for (int i = 0; i < 4; ++i) { v[i] = *(const f32x4*)(src + i * 256 + lane * 4); ss += v[i][0] * v[i][0] + v[i][1] * v[i][1] + v[i][2] * v[i][2] + v[i][3] * v[i][3]; }
#pragma unroll
          for (int o = 1; o < 64; o <<= 1) ss += __shfl_xor(ss, o);
          const float rr = rsqrtf(ss * (1.0f / DM) + EPS);
#pragma unroll
          for (int i = 0; i < 4; ++i) { const f32x4 gv = *(const f32x4*)(gg + i * 256 + lane * 4);
            u32x2 w; w.x = cvt_pk(v[i][0] * rr * gv[0], v[i][1] * rr * gv[1]); w.y = cvt_pk(v[i][2] * rr * gv[2], v[i][3] * rr * gv[3]);
            *(u32x2*)(dst + i * 256 + lane * 4) = w; }
        }
      } else if (p == 1) {
        PHASE_AP
        { pg8::GridOrder S_; S_.init(H, DM, WIN, DM, TU, NG1, G, cu); pg8::EpiG1a E{QB, KVB, ap->in[6] + l * 64, ap->in[16] + l * 64, ap->in[19] + l * 64, ap->in[7] + l * 64, ap->in[17] + l * 64, ap->in[20] + l * 64}; pg8::gemm_phase(lds, pg8::Gemm{DM, DM, DM}, S_, E); }
        { pg8::GridOrder S_; S_.init(MN, DM, WMEM, DM, nmem, 1024, G, (cu + 64) % G); pg8::EpiPlain E{MKV, PMKV}; pg8::gemm_phase(lds, pg8::Gemm{DM, DM, DM}, S_, E); }
      } else if (p == 2) {
        PHASE_AP
        const float sc64 = 0.125f * LOG2E, sc128 = 0.08838834764831845f * LOG2E;
        const float* a_qn = ap->in[6] + l * 64; const float* a_kn = ap->in[7] + l * 64; const float* b_cqn = ap->in[10] + l * 256; const float* b_ckvn = ap->in[11] + l * 128;
        const float* b_kn = ap->in[15] + l * 96; const float* c_qn = ap->in[16] + l * 64; const float* c_kn = ap->in[17] + l * 64; const float* d_qn = ap->in[19] + l * 64;
        const float* d_kn = ap->in[20] + l * 64; const float* m_qn = ap->in[23] + l * 128; const float* m_kn = ap->in[24] + l * 128;
        const int c8 = (lane & 7) * 8, c16 = (lane & 15) * 8;
        for (int row = cu * 8 + wid; row < TU + nmem; row += G * 8) {
          if (row >= TU) { bf16_t* pk_ = MKV + (size_t)(row - TU) * PMKV + lane * 8; seg_norm<16>(pk_, pk_, true, m_kn + c16, 1.f, nullptr); continue; }
          bf16_t* qb = QB + (size_t)row * PQ + lane * 8; bf16_t* kv = KVB + (size_t)row * PKV + lane * 8;
          const u32x4 r5 = ldraw(qb + QC_MQ, true), r11 = ldraw(kv + KC_CQ, lane < 32), r12 = ldraw(kv + KC_CKV, lane < 16), r13 = ldraw(kv + KC_KR, lane < 4);
          seg_norm<16>(nullptr, qb + QC_MQ, true, m_qn + c16, sc128, nullptr, &r5);
          seg_norm<32>(nullptr, kv + KC_CQ, lane < 32, b_cqn + (lane & 31) * 8, 1.f, nullptr, &r11);
          seg_norm<16>(nullptr, kv + KC_CKV, lane < 16, b_ckvn + c16, 1.f, nullptr, &r12);
          { float v[8]; seg_norm<4>(nullptr, nullptr, lane < 4, b_kn + 64 + (lane & 3) * 8, 1.f, v, &r13);
            const float* rp = ROPE + (size_t)(row % S) * 32; rope4(v, lane & 3, rp, rp + 16);
            if (lane < 4) *(u32x4*)(kv + KC_KR) = pack8(v); }
        }
      } else if (p == 3) {
        PHASE_AP
        pg8::GridOrder S_; S_.init(KVB + KC_CQ, PKV, WMLA, 384, TU, PMLA, G, cu); pg8::EpiPlain E{MLA, PMLA}; pg8::gemm_phase(lds, pg8::Gemm{PKV, 384, 384}, S_, E);
      } else if (p == 4) {
        PHASE_AP
        const float scb = 0.10206207261596575f * LOG2E, sc128 = 0.08838834764831845f * LOG2E;
        const float* b_qn = ap->in[14] + l * 96; const float* b_kn = ap->in[15] + l * 96; const float* m_qn = ap->in[23] + l * 128; const float* m_kn = ap->in[24] + l * 128;
        const int c16 = (lane & 15) * 8;
        for (int row = cu * 8 + wid; row < TU + nmem; row += G * 8) {
          if (row >= TU) { bf16_t* pk_ = MKV + (size_t)(row - TU) * PMKV + lane * 8; seg_norm<16>(pk_, pk_, true, m_kn + c16, 1.f, nullptr); continue; }
          bf16_t* ml = MLA + (size_t)row * PMLA; bf16_t* bk = BK + (size_t)row * PBK; const bf16_t* kvrow = KVB + (size_t)row * PKV; bf16_t* pmq = QB + (size_t)row * PQ + QC_MQ + lane * 8;
          const float* rp = ROPE + (size_t)(row % S) * 32;
          const int hd8 = (lane >> 3) & 3, ch8 = lane & 7, hd4 = (lane >> 2) & 3, ch4 = lane & 3;
          bf16_t* pqn = ml + hd8 * 96 + ch8 * 8; bf16_t* pqr = ml + hd4 * 96 + 64 + ch4 * 8; bf16_t* pv_ = ml + 384 + (lane >> 4) * 192 + 64 + c16;
          const u32x4 rcq = ldraw(kvrow + KC_CQ + lane * 8, lane < 32), rckv = ldraw(kvrow + KC_CKV + lane * 8, lane < 16), rkr = ldraw(kvrow + KC_KR + ch4 * 8, lane < 16), rmq = ldraw(pmq, true),
                      q0r = ldraw(pqn, lane < 32), q1r = ldraw(pqr, lane < 16), q2r = ldraw(ml + 384 + hd8 * 192 + ch8 * 8, lane < 32), rvv = ldraw(pv_, true);
          float sq = 0.f, skv = 0.f;
          { float t8[8]; unpack8(rcq, t8);
#pragma unroll
            for (int i = 0; i < 8; ++i) sq += t8[i] * t8[i];
            unpack8(rckv, t8);
#pragma unroll
            for (int i = 0; i < 8; ++i) skv += t8[i] * t8[i]; }
#pragma unroll
          for (int o = 1; o < 64; o <<= 1) { sq += __shfl_xor(sq, o); skv += __shfl_xor(skv, o); }
          const float r_q = rsqrtf(sq * (1.0f / 256.0f) + EPS), r_kv = rsqrtf(skv * (1.0f / 128.0f) + EPS);
          seg_norm<8>(nullptr, pqn, lane < 32, b_qn + ch8 * 8, scb, nullptr, &q0r, r_q);
          { float v[8]; seg_norm<4>(nullptr, nullptr, lane < 16, b_qn + 64 + ch4 * 8, 1.f, v, &q1r, r_q);
            rope4(v, ch4, rp, rp + 16);
#pragma unroll
            for (int i = 0; i < 8; ++i) v[i] *= scb;
            if (lane < 16) *(u32x4*)pqr = pack8(v); }
          seg_norm<8>(nullptr, bk + hd8 * 96 + ch8 * 8, lane < 32, b_kn + ch8 * 8, 1.f, nullptr, &q2r, r_kv);
          { float v[8]; seg_norm<4>(nullptr, nullptr, lane < 16, b_kn + 64 + ch4 * 8, 1.f, v, &rkr);
            rope4(v, ch4, rp, rp + 16);
            if (lane < 16) *(u32x4*)(bk + hd4 * 96 + 64 + ch4 * 8) = pack8(v); }
          { float v[8]; unpack8(rvv, v);
#pragma unroll
            for (int i = 0; i < 8; ++i) v[i] *= r_kv;
            *(u32x4*)pv_ = pack8(v); }
          seg_norm<16>(nullptr, pmq, true, m_qn + c16, sc128, nullptr, &rmq);
        }
      } else if (p == 5) {
        PHASE_AP
        const int nqb = S / 256, per = nseq * nqb;
        const int nB = per * 4, nA = per * 8, nC = per * 8, nD = per * 24, nM = per * 4, ntot = nB + nA + nC + nD + nM;
        const float* sink = ap->in[18] + l * 8;
        const int BIGW = 1 << 28;
        float gq = fabsf((ap->in[6] + l * 64)[lane]), gk = fabsf((ap->in[7] + l * 64)[lane]);
#pragma unroll
        for (int o = 1; o < 64; o <<= 1) { gq = fmaxf(gq, __shfl_xor(gq, o)); gk = fmaxf(gk, __shfl_xor(gk, o)); }
        const float athr = 2.0f * (8.0f * gq * gk * 1.02f) + 104.0f;
        float gbq = fmaxf(fabsf((ap->in[14] + l * 96)[lane]), fabsf((ap->in[14] + l * 96)[64 + (lane & 31)])), gbk = fmaxf(fabsf((ap->in[15] + l * 96)[lane]), fabsf((ap->in[15] + l * 96)[64 + (lane & 31)]));
        float gcq = fabsf((ap->in[16] + l * 64)[lane]), gck = fabsf((ap->in[17] + l * 64)[lane]), gdq = fabsf((ap->in[19] + l * 64)[lane]), gdk = fabsf((ap->in[20] + l * 64)[lane]);
        float gmq = fmaxf(fabsf((ap->in[23] + l * 128)[lane]), fabsf((ap->in[23] + l * 128)[64 + lane])), gmk = fmaxf(fabsf((ap->in[24] + l * 128)[lane]), fabsf((ap->in[24] + l * 128)[64 + lane]));
#pragma unroll
        for (int o = 1; o < 64; o <<= 1) { gbq = fmaxf(gbq, __shfl_xor(gbq, o)); gbk = fmaxf(gbk, __shfl_xor(gbk, o)); gcq = fmaxf(gcq, __shfl_xor(gcq, o)); gck = fmaxf(gck, __shfl_xor(gck, o));
          gdq = fmaxf(gdq, __shfl_xor(gdq, o)); gdk = fmaxf(gdk, __shfl_xor(gdk, o)); gmq = fmaxf(gmq, __shfl_xor(gmq, o)); gmk = fmaxf(gmk, __shfl_xor(gmk, o)); }
        const float smA = 8.0f * gq * gk * (LOG2E * 1.02f), smB = 9.797959f * gbq * gbk * (LOG2E * 1.02f), smC = 8.0f * gcq * gck * (LOG2E * 1.02f),
                    smD = 8.0f * gdq * gdk * (LOG2E * 1.02f), smM = 11.313708f * gmq * gmk * (LOG2E * 1.02f);
        unsigned* qctr = (unsigned*)(ap->ws + 32768) + (l * 3 + u) * 64;
        volatile LAS unsigned* qslot = (volatile LAS unsigned*)(lds + 131072 + 16);
        for (;;) {
          __syncthreads();
          if (tid == 0) qslot[0] = atomicAdd(qctr, 1u);
          __syncthreads();
          const int it = (int)qslot[0];
          if (it >= ntot) break;
          int j = it;
          if (j < nB) {
            const int blk = j % nqb, hh = (j / nqb) % 4, b = j / (nqb * 4); const size_t r0 = (size_t)b * S;
            attn_item<96, 128, false, false, false>(lds, MLA + r0 * PMLA + hh * 96, PMLA, BK + r0 * PBK + hh * 96, PBK, MLA + r0 * PMLA + 384 + hh * 192 + 64, PMLA,
                               QB + r0 * PQ + QC_OB + hh * 128, PQ, nullptr, 0, blk * 256, S, BIGW, 0.f, 0.f, 0.f);
            continue; }
          j -= nB;
          if (j < nA) {
            const int blk = j % nqb, mm = (j / nqb) & 1, b = (j / (nqb * 2)) % nseq, hh = 3 - j / (nqb * 2 * nseq); const size_t r0 = (size_t)b * S;
            const float sn = exp2f(-2.0f * (hh + 1)), slope = sn * LOG2E; const float wf = athr / sn + 2.0f; const int Wa = wf > 1e8f ? BIGW : (int)wf;
            attn_item<64, 128, true, false, true>(lds, QB + r0 * PQ + QC_AQ + mm * 256 + hh * 64, PQ, KVB + r0 * PKV + KC_AK + mm * 256 + hh * 64, PKV, KVB + r0 * PKV + KC_AV + hh * 128, PKV,
                               QB + r0 * PQ + QC_OA + mm * 512 + hh * 128, PQ, nullptr, 0, blk * 256, S, Wa, slope, 0.f, 0.f);
            continue; }
          j -= nA;
          if (j < nC) {
            const int blk = j % nqb, hq = (j / nqb) % 8, b = j / (nqb * 8), kvh = hq >> 2; const size_t r0 = (size_t)b * S;
            const float slope = exp2f(-(float)(hq + 1)) * LOG2E; const float sk2 = sink[hq] * LOG2E, mC = fmaxf(smC, sk2);
            attn_item<64, 64, true, true, false>(lds, QB + r0 * PQ + QC_CQ + hq * 64, PQ, KVB + r0 * PKV + KC_CK + kvh * 64, PKV, KVB + r0 * PKV + KC_CV + kvh * 64, PKV,
                              QB + r0 * PQ + QC_CQ + hq * 64, PQ, nullptr, 0, blk * 256, S, 128, slope, 0.f, exp2f(sk2));
            continue; }
          j -= nC;
          if (j < nD) {
            const int blk = j % nqb, gh = (j / nqb) % 24, b = j / (nqb * 24), gg = gh >> 3, hh = gh & 7;
            const int dil = gg == 0 ? 1 : gg == 1 ? 4 : 16; const int Ls = S / dil, nbr = Ls / 256, res = blk / nbr, qbk = blk % nbr;
            const size_t r0 = (size_t)b * S + res; const float slope = exp2f(-(float)(hh + 1)) * LOG2E * (float)dil;
            attn_item<64, 64, true, true, false>(lds, QB + r0 * PQ + QC_DQ + gg * 512 + hh * 64, PQ * dil, KVB + r0 * PKV + KC_DK + gg * 512 + hh * 64, PKV * dil, KVB + r0 * PKV + KC_DV + gg * 512 + hh * 64, PKV * dil,
                              QB + r0 * PQ + QC_DQ + gg * 512 + hh * 64, PQ * dil, LSE + r0 * 24 + gg * 8 + hh, 24 * dil, qbk * 256, Ls, 64, slope, 0.f, 0.f);
            continue; }
          j -= nD;
          { const int blk = j % nqb, hh = (j / nqb) % 4, b = j / (nqb * 4); const size_t r0 = (size_t)b * S;
            attn_item<128, 128, false, false, false>(lds, QB + r0 * PQ + QC_MQ + hh * 128, PQ, MKV + (size_t)b * 256 * PMKV + hh * 128, PMKV, MKV + (size_t)b * 256 * PMKV + 512 + hh * 128, PMKV,
                                QB + r0 * PQ + QC_MQ + hh * 128, PQ, nullptr, 0, blk * 256, 256, BIGW, 0.f, 0.f, 0.f); }
        }
      } else if (p == 6) {
        PHASE_AP
        const float* lf = ap->in[8] + l * 256; const float* a_hn = ap->in[9] + l * 128;
        float d01 = lf[lane] * lf[64 + lane], d23 = lf[128 + lane] * lf[192 + lane];
#pragma unroll
        for (int o = 1; o < 64; o <<= 1) { d01 += __shfl_xor(d01, o); d23 += __shfl_xor(d23, o); }
        const float lam_init = 0.8f - 0.6f * expf(-0.3f * (float)l);
        const float lam = expf(d01) - expf(d23) + lam_init;
        const int c16 = (lane & 15) * 8;
        for (int row = cu * 8 + wid; row < TU; row += G * 8) {
          bf16_t* qb = QB + (size_t)row * PQ;
          bf16_t* pA = qb + QC_OA + lane * 8; bf16_t* pD = qb + QC_DQ + lane * 8;
          const u32x4 ra0 = *(const u32x4*)pA, ra1 = *(const u32x4*)(pA + 512), rd0 = *(const u32x4*)pD, rd1 = *(const u32x4*)(pD + 512), rd2 = *(const u32x4*)(pD + 1024);
          const int hd = lane >> 3; const float* ls = LSE + (size_t)row * 24 + hd; const float l0 = ls[0], l1 = ls[8], l2 = ls[16];
          { float a0[8], a1[8]; unpack8(ra0, a0); unpack8(ra1, a1);
            float ss = 0.f;
#pragma unroll
            for (int i = 0; i < 8; ++i) { a0[i] = a0[i] - lam * a1[i]; ss += a0[i] * a0[i]; }
#pragma unroll
            for (int o = 1; o < 16; o <<= 1) ss += __shfl_xor(ss, o);
            const float rr = rsqrtf(ss * (1.0f / 128.0f) + EPS) * (1.0f - lam_init);
#pragma unroll
            for (int i = 0; i < 8; ++i) a0[i] = a0[i] * rr * a_hn[c16 + i];
            *(u32x4*)pA = pack8(a0); }
          { const float mx = fmaxf(l0, fmaxf(l1, l2)); float w0 = fexp2(l0 - mx), w1 = fexp2(l1 - mx), w2 = fexp2(l2 - mx); const float iw = 1.0f / (w0 + w1 + w2);
            w0 *= iw; w1 *= iw; w2 *= iw;
            float a0[8], a1[8], a2[8]; unpack8(rd0, a0); unpack8(rd1, a1); unpack8(rd2, a2);
#pragma unroll
            for (int i = 0; i < 8; ++i) a0[i] = w0 * a0[i] + w1 * a1[i] + w2 * a2[i];
            *(u32x4*)pD = pack8(a0); }
        }
        __syncthreads();
        { pg8::GridOrder S_; S_.init(H, DM, WIN + (size_t)(NG1 + NZ) * DM, DM, TU, NGT, G, cu); pg8::EpiGate E{GATE, ap->in[25] + (size_t)l * 5 * DM}; pg8::gemm_phase(lds, pg8::Gemm{DM, DM, DM}, S_, E); }
      } else if (p == 7) {
        PHASE_AP
        pg8::GridOrder S_; S_.init(H, DM, WIN + (size_t)NG1 * DM, DM, TU, NZ, G, cu); pg8::EpiZ E{QB}; pg8::gemm_phase(lds, pg8::Gemm{DM, DM, DM}, S_, E);
      } else if (p == 8) {
        PHASE_AP
        pg8::MergeOrder S_{(const char*)QB, (const char*)WBR, (TU / 256) * 4, G, cu}; pg8::EpiMerge E{H, GATE, (ap->pad >> 8) & 31}; pg8::gemm_phase(lds, pg8::Gemm{PQ, 512, 512}, S_, E);
      } else {
        PHASE_AP
        const float* xin = XIN; float* xout = XOUT;
        pg8::GridOrder S_; S_.init(H, DM, WOUT, DM, TU, DM, G, cu); pg8::EpiOut E{xin, xout}; pg8::gemm_phase(lds, pg8::Gemm{DM, DM, DM}, S_, E);
      }
    }
    if (ap0->coop && ph + 1 < ph_hi) { if (ap0->coop == 2) grid_sync(); else xcd_barrier(xbar); }
#ifdef DBG
    {
      CArgsP ap = ap0; unsigned* DB = (unsigned*)(ap->ws + WS_DBG);
      int tid = threadIdx.x; const int lane = tid & 63, wid = tid >> 6; const int G = gridDim.x, cu = blockIdx.x;
      if (ph + 1 >= ph_hi) grid_sync();
      if (ph == 0) { if (cu == 0 && tid < 16) DB[tid] = 0u; }
      if (ph == 2) {
        for (int s = cu * 512 + tid; s < 32768; s += G * 512) {
          const unsigned hsh = dbg_hash(s * 2654435761u + 17u); const int t = hsh % TU, n = (hsh >> 14) % (NG1 - 96);
          float ref = 0.f; for (int k = 0; k < DM; ++k) ref += bf2f(H[(size_t)t * DM + k]) * bf2f(WIN[(size_t)n * DM + k]);
          const float got = n < 3072 ? bf2f(QB[(size_t)t * PQ + n]) : bf2f(KVB[(size_t)t * PKV + n - 3072]);
          dbg_max(DB + 0, fabsf(got - ref) / (fabsf(ref) + 0.05f));
        }
        for (int s = cu * 512 + tid; s < 8192; s += G * 512) {
          const unsigned hsh = dbg_hash(s * 2654435761u + 99u); const int t = hsh % 1024, n = (hsh >> 14) % 1024;
          float ref = 0.f; for (int k = 0; k < DM; ++k) ref += bf2f(MN[(size_t)t * DM + k]) * bf2f(WMEM[(size_t)n * DM + k]);
          dbg_max(DB + 3, fabsf(bf2f(MKV[(size_t)t * PMKV + n]) - ref) / (fabsf(ref) + 0.05f));
        }
      }
      if (ph == 4) {
        for (int s = cu * 512 + tid; s < 32768; s += G * 512) {
          const unsigned hsh = dbg_hash(s * 2654435761u + 5u); const int t = hsh % TU, n = (hsh >> 14) % 1152;
          float ref = 0.f; for (int k = 0; k < 384; ++k) ref += bf2f(KVB[(size_t)t * PKV + KC_CQ + k]) * bf2f(WMLA[(size_t)n * 384 + k]);
          dbg_max(DB + 4, fabsf(bf2f(MLA[(size_t)t * PMLA + n]) - ref) / (fabsf(ref) + 0.05f));
        }
      }
      if (ph == 6) {
        const int S = 4096, nqb = 16, per = 64, nB = per * 4, nA = per * 8; LAS float* sc = (LAS float*)lds;
        if (wid == 0) for (int it = cu; it < nB + nA; it += G) {
          const int rq = (it * 97 + 13) & 255; float e;
          if (it < nB) { const int j = it, blk = j % nqb, hh = (j / nqb) % 4, b = j / (nqb * 4); const size_t r0 = (size_t)b * S;
            e = dbg_attn_row<96, 128>(sc, MLA + r0 * PMLA + hh * 96, PMLA, BK + r0 * PBK + hh * 96, PBK, MLA + r0 * PMLA + 384 + hh * 192 + 64, PMLA, QB + r0 * PQ + QC_OB + hh * 128, PQ,
                                      blk * 256 + rq, S, 1 << 28, 0.f, -1e30f, 0.f, lane);
            if (lane == 0) dbg_max(DB + 2, e);
          } else { const int j = it - nB, blk = j % nqb, mh = (j / nqb) % 8, b = j / (nqb * 8), mm = mh >> 2, hh = mh & 3; const size_t r0 = (size_t)b * S;
            const float slope = exp2f(-2.0f * (hh + 1)) * LOG2E;
            e = dbg_attn_row<64, 128>(sc, QB + r0 * PQ + QC_AQ + mm * 256 + hh * 64, PQ, KVB + r0 * PKV + KC_AK + mm * 256 + hh * 64, PKV, KVB + r0 * PKV + KC_AV + hh * 128, PKV,
                                      QB + r0 * PQ + QC_OA + mm * 512 + hh * 128, PQ, blk * 256 + rq, S, 1 << 28, slope, -1e30f, 0.f, lane);
            if (lane == 0) dbg_max(DB + 1, e);
          }
        }
      }
      if (ph == 7) {
        const float* bg = ap->in[25];
        for (int s = cu * 512 + tid; s < 32768; s += G * 512) {
          const unsigned hsh = dbg_hash(s * 2654435761u + 7u); const int t = hsh % TU, n = (hsh >> 14) % NGT;
          float ref = 0.f; for (int k = 0; k < DM; ++k) ref += bf2f(H[(size_t)t * DM + k]) * bf2f(WIN[(size_t)(NG1 + NZ + n) * DM + k]);
          ref = 1.f / (1.f + expf(-(ref + bg[n])));
          dbg_max(DB + 8, fabsf(bf2f(GATE[(size_t)t * PGATE + n]) - ref) / (fabsf(ref) + 0.05f));
        }
      }
      if (ph == 9) {
        for (int s = cu * 512 + tid; s < 32768; s += G * 512) {
          const unsigned hsh = dbg_hash(s * 2654435761u + 9u); const int t = hsh % TU, c = (hsh >> 14) % DM;
          float ref = 0.f;
          for (int br = 0; br < 5; ++br) { const int ocol = br == 0 ? QC_OA : br == 1 ? QC_OB : br == 2 ? QC_CQ : br == 3 ? QC_DQ : QC_MQ;
            float tt = 0.f; for (int k = 0; k < 512; ++k) tt += bf2f(QB[(size_t)t * PQ + ocol + k]) * bf2f(WBR[(size_t)(br * 1024 + c) * 512 + k]);
            ref += bf2f(GATE[(size_t)t * PGATE + br * 1024 + c]) * tt; }
          dbg_max(DB + 9, fabsf(bf2f(H[(size_t)t * DM + c]) - ref) / (fabsf(ref) + 0.05f));
        }
      }
      if (ph == 10) {
        for (int s = cu * 512 + tid; s < 32768; s += G * 512) {
          const unsigned hsh = dbg_hash(s * 2654435761u + 11u); const int t = hsh % TU, c = (hsh >> 14) % DM;
          float ref = 0.f; for (int k = 0; k < DM; ++k) ref += bf2f(H[(size_t)t * DM + k]) * bf2f(WOUT[(size_t)c * DM + k]);
          ref += ap->in[0][(size_t)t * DM + c];
          dbg_max(DB + 10, fabsf(ap->out[(size_t)t * DM + c] - ref) / (fabsf(ref) + 0.05f));
        }
      }
      if (ph == 2 || ph == 4 || ph == 6 || ph == 0 || ph == 7 || ph == 9) grid_sync();
      if (ph + 1 == ph_hi) {
        grid_sync();
        const float e1 = __uint_as_float(DB[DBG_SEL1]), e2 = __uint_as_float(DB[DBG_SEL2]);
        const float k1 = fminf(fmaxf(log10f(e1 + 1e-30f) + 5.f, 0.f), 7.f), k2 = fminf(fmaxf(log10f(e2 + 1e-30f) + 5.f, 0.f), 7.f);
        for (size_t i = (size_t)cu * 512 + tid; i < (size_t)49152 * DM; i += (size_t)G * 512) {
          const float xv = i < (size_t)TU * DM ? ap->in[0][i] : ap->in[1][i - (size_t)TU * DM];
          ap->out[i] = (i == 0) ? 100.f * k2 : xv * (1.f + k1);
        }
      }
    }
#endif
  }
}

extern "C" void kernel_launch(void* const* d_in, const int* in_sizes, int n_in, void* d_out, int out_size, void* d_ws, size_t ws_size, hipStream_t stream) {
  static int grid = 0;
  if (!grid) {
    if (n_in != 28 || ws_size < WS_END) { fprintf(stderr, "kernel_launch: unexpected n_in %d or ws_size %zu (< %zu)\n", n_in, ws_size, (size_t)WS_END); grid = -1; }
    else {
      int dev = 0, cus = 0, per_cu = 0;
      hipGetDevice(&dev); hipDeviceGetAttribute(&cus, hipDeviceAttributeMultiprocessorCount, dev);
      hipFuncSetAttribute((const void*)mega, hipFuncAttributeMaxDynamicSharedMemorySize, LDS_BYTES);
      hipOccupancyMaxActiveBlocksPerMultiprocessor(&per_cu, mega, 512, LDS_BYTES);
      grid = cus * (per_cu > 0 ? 1 : 0);
      if (grid > 256) grid = 256;
      if (grid <= 0) { fprintf(stderr, "kernel_launch: occupancy query says %d blocks/CU\n", per_cu); grid = -1; }
    }
  }
  if (grid <= 0) return;
  Args a{};
  for (int i = 0; i < 28; ++i) a.in[i] = (const float*)d_in[i];
  a.out = (float*)d_out; a.ws = (unsigned char*)d_ws; a.ph_lo = 0; a.ph_hi = DBG_PH_HI; a.coop = 1; a.pad = 31 | (DBG_BMASK << 8);
  if (hipMemsetAsync(d_ws, 0, 65536, stream) != hipSuccess) { fprintf(stderr, "kernel_launch: memset of barrier words failed\n"); return; }
  void* params[] = {&a};
  hipError_t e = hipLaunchCooperativeKernel((const void*)mega, dim3(grid), dim3(512), params, LDS_BYTES, stream);
  if (e != hipSuccess) fprintf(stderr, "cooperative launch failed: %s (grid %d)\n", hipGetErrorString(e), grid);
}
```
